# Optimizing an MI355X kernel written in HIP

```python
import jax, jax.numpy as jnp
from jax import lax
import numpy as np

D_MODEL = 1024
BATCH = 4
SEQ = 8192
DEPTH = 2

D_RNN = 1408
RNN_BLOCKS = 16
RNN_BW = D_RNN // RNN_BLOCKS
CONV_WIDTH = 4
LRU_C = 8.0
N_HEADS = 16
HEAD_DIM = 64
N_KV_GROUPS = 4
HEADS_PER_GROUP = N_HEADS // N_KV_GROUPS
CMP_BLOCK = 32
CMP_STRIDE = 16
CMP_HIDDEN = 256
SEL_BLOCK = 64
N_SEL = 16
WINDOW = 512
Q_BLOCK = 128
SEL_Q_BLOCK = 32
FORCE_SCORE = 1.0e4
ROPE_THETA = 10000.0
NSA_IN = N_HEADS * HEAD_DIM + 6 * N_KV_GROUPS * HEAD_DIM + 3 * N_HEADS
D_FF = 3584
N_EXPERTS = 8
TOP_K = 2
RMS_EPS = 1e-6

kernel_name = "hybrid_rglru_nsa_moe_trunk"


def rmsnorm(x, g):
    xf = x.astype(jnp.float32)
    y = xf * lax.rsqrt(jnp.mean(xf * xf, axis=-1, keepdims=True) + RMS_EPS)
    return (y * g.astype(jnp.float32)).astype(x.dtype)


def rope(x, pos):
    half = HEAD_DIM // 2
    freqs = ROPE_THETA ** (-jnp.arange(half, dtype=jnp.float32) / half)
    ang = pos[:, None] * freqs[None, :]
    cos = jnp.cos(ang)[None, :, None, :].astype(x.dtype)
    sin = jnp.sin(ang)[None, :, None, :].astype(x.dtype)
    x1, x2 = x[..., :half], x[..., half:]
    return jnp.concatenate([x1 * cos - x2 * sin, x2 * cos + x1 * sin], axis=-1)


def masked_softmax(s, mask):
    s = jnp.where(mask, s.astype(jnp.float32), -jnp.inf)
    m = jnp.max(s, axis=-1, keepdims=True)
    m = jnp.where(jnp.isfinite(m), m, 0.0)
    e = jnp.where(mask, jnp.exp(s - m), 0.0)
    return e / jnp.maximum(jnp.sum(e, axis=-1, keepdims=True), 1e-30)


def rglru_mixer(x, w_in, b_in, conv_w, conv_b, w_a, b_a, w_i, b_i, lam, w_out, b_out):
    B, S, _ = x.shape
    proj = x @ w_in + b_in
    gate, xr = jnp.split(proj, 2, axis=-1)
    gate = jax.nn.gelu(gate)
    xp = jnp.pad(xr, ((0, 0), (CONV_WIDTH - 1, 0), (0, 0)))
    xc = conv_b + sum(xp[:, k:k + S] * conv_w[k] for k in range(CONV_WIDTH))
    xb = xc.reshape(B, S, RNN_BLOCKS, RNN_BW)
    r = jax.nn.sigmoid(jnp.einsum('bsnc,ncd->bsnd', xb, w_a).reshape(B, S, D_RNN) + b_a)
    i = jax.nn.sigmoid(jnp.einsum('bsnc,ncd->bsnd', xb, w_i).reshape(B, S, D_RNN) + b_i)
    log_a = (-LRU_C * r.astype(jnp.float32)) * jax.nn.softplus(-lam.astype(jnp.float32))
    a = jnp.exp(log_a)
    mult = jnp.sqrt(-jnp.expm1(2.0 * log_a))
    mult = mult.at[:, 0].set(1.0)
    u = mult * (i * xc).astype(jnp.float32)

    def combine(lhs, rhs):
        a1, b1 = lhs
        a2, b2 = rhs
        return a1 * a2, a2 * b1 + b2

    _, h = lax.associative_scan(combine, (a, u), axis=1)
    y = h.astype(x.dtype) * gate
    return y @ w_out + b_out


def compress(t, pe, w1, w2):
    B, S, G, D = t.shape
    r = CMP_BLOCK // CMP_STRIDE
    n_ch = S // CMP_STRIDE
    ch = t.reshape(B, n_ch, CMP_STRIDE, G, D)
    blk = jnp.concatenate([ch[:, j:n_ch - r + 1 + j] for j in range(r)], axis=2)
    blk = blk + pe[None, None, :, None, :]
    flat = blk.transpose(0, 1, 3, 2, 4).reshape(B, n_ch - r + 1, G, CMP_BLOCK * D)
    return jax.nn.gelu(flat @ w1) @ w2


def overlap_matrix(n_c, n_s):
    r = CMP_BLOCK // CMP_STRIDE
    qn = SEL_BLOCK // CMP_STRIDE
    chunks = np.arange(n_c)[:, None] + np.arange(r)[None, :]
    m = np.zeros((n_c, n_s), np.float32)
    np.add.at(m, (np.repeat(np.arange(n_c), r), (chunks // qn).ravel()), 1.0)
    return m


def nsa_mixer(x, w_in, cmp_pe, cmp_w1, cmp_w2, w_out):
    B, S, _ = x.shape
    H, G, HP, DH = N_HEADS, N_KV_GROUPS, HEADS_PER_GROUP, HEAD_DIM
    proj = x @ w_in
    cuts = list(np.cumsum([H * DH] + [G * DH] * 6))
    q, kc, vc, ks, vs, kw, vw, g = jnp.split(proj, cuts, axis=-1)
    q = q.reshape(B, S, H, DH)
    kc, vc, ks, vs, kw, vw = [t.reshape(B, S, G, DH) for t in (kc, vc, ks, vs, kw, vw)]
    gates = jax.nn.sigmoid(g.reshape(B, S, H, 3))
    pos = jnp.arange(S, dtype=jnp.float32)
    q = rope(q, pos) * (DH ** -0.5)
    kc, ks, kw = rope(kc, pos), rope(ks, pos), rope(kw, pos)
    qg = q.reshape(B, S, G, HP, DH)

    k_cmp = compress(kc, cmp_pe[0], cmp_w1[0], cmp_w2[0])
    v_cmp = compress(vc, cmp_pe[1], cmp_w1[1], cmp_w2[1])
    n_c = k_cmp.shape[1]
    n_s = S // SEL_BLOCK
    k_sel = min(N_SEL, n_s)
    cmp_end = jnp.arange(n_c) * CMP_STRIDE + CMP_BLOCK - 1
    blk_start = jnp.arange(n_s) * SEL_BLOCK
    overlap = jnp.asarray(overlap_matrix(n_c, n_s))

    def cmp_block(i):
        s0 = i * Q_BLOCK
        qb = lax.dynamic_slice_in_dim(qg, s0, Q_BLOCK, axis=1)
        t = s0 + jnp.arange(Q_BLOCK)
        sc = jnp.einsum('bqghd,bcgd->bghqc', qb, k_cmp)
        p = masked_softmax(sc, cmp_end[None, :] <= t[:, None])
        o = jnp.einsum('bghqc,bcgd->bqghd', p.astype(v_cmp.dtype), v_cmp)
        imp = jnp.einsum('bghqc,cn->bgqn', p, overlap)
        cur = t[:, None] // SEL_BLOCK
        j = jnp.arange(n_s)[None, :]
        forced = (j == 0) | (j == cur) | (j == cur - 1)
        valid = blk_start[None, :] <= t[:, None]
        score = jnp.where(forced, FORCE_SCORE, jnp.where(valid, imp, -1.0))
        _, idx = lax.top_k(score, k_sel)
        return o, idx

    o_cmp, sel_idx = lax.map(cmp_block, jnp.arange(S // Q_BLOCK))
    o_cmp = o_cmp.transpose(1, 0, 2, 3, 4, 5).reshape(B, S, H, DH)
    sel_idx = sel_idx.transpose(1, 2, 0, 3, 4).reshape(B, G, S, k_sel)

    kb = ks.reshape(B, n_s, SEL_BLOCK, G, DH).transpose(0, 3, 1, 2, 4)
    vb = vs.reshape(B, n_s, SEL_BLOCK, G, DH).transpose(0, 3, 1, 2, 4)
    bi = jnp.arange(B)[:, None, None, None]
    gi = jnp.arange(G)[None, :, None, None]

    def sel_block(i):
        s0 = i * SEL_Q_BLOCK
        qb = lax.dynamic_slice_in_dim(qg, s0, SEL_Q_BLOCK, axis=1)
        idx = lax.dynamic_slice_in_dim(sel_idx, s0, SEL_Q_BLOCK, axis=2)
        t = s0 + jnp.arange(SEL_Q_BLOCK)
        kg = kb[bi, gi, idx]
        vg = vb[bi, gi, idx]
        sc = jnp.einsum('bqghd,bgqkld->bghqkl', qb, kg)
        kpos = idx[..., None] * SEL_BLOCK + jnp.arange(SEL_BLOCK)
        mask = kpos <= t[None, None, :, None, None]
        n_k = k_sel * SEL_BLOCK
        p = masked_softmax(sc.reshape(B, G, HP, SEL_Q_BLOCK, n_k),
                           mask[:, :, None].reshape(B, G, 1, SEL_Q_BLOCK, n_k))
        return jnp.einsum('bghqn,bgqnd->bqghd', p.astype(vg.dtype),
                          vg.reshape(B, G, SEL_Q_BLOCK, n_k, DH))

    o_sel = lax.map(sel_block, jnp.arange(S // SEL_Q_BLOCK))
    o_sel = o_sel.transpose(1, 0, 2, 3, 4, 5).reshape(B, S, H, DH)

    kw_p = jnp.pad(kw, ((0, 0), (WINDOW, 0), (0, 0), (0, 0)))
    vw_p = jnp.pad(vw, ((0, 0), (WINDOW, 0), (0, 0), (0, 0)))
    span = WINDOW + Q_BLOCK

    def win_block(i):
        s0 = i * Q_BLOCK
        qb = lax.dynamic_slice_in_dim(qg, s0, Q_BLOCK, axis=1)
        kb_ = lax.dynamic_slice_in_dim(kw_p, s0, span, axis=1)
        vb_ = lax.dynamic_slice_in_dim(vw_p, s0, span, axis=1)
        t = s0 + jnp.arange(Q_BLOCK)
        kpos = s0 - WINDOW + jnp.arange(span)
        d = t[:, None] - kpos[None, :]
        mask = (kpos[None, :] >= 0) & (d >= 0) & (d < WINDOW)
        sc = jnp.einsum('bqghd,bkgd->bghqk', qb, kb_)
        p = masked_softmax(sc, mask)
        return jnp.einsum('bghqk,bkgd->bqghd', p.astype(vb_.dtype), vb_)

    o_win = lax.map(win_block, jnp.arange(S // Q_BLOCK))
    o_win = o_win.transpose(1, 0, 2, 3, 4, 5).reshape(B, S, H, DH)

    gates = gates.astype(x.dtype)
    o = gates[..., 0, None] * o_cmp + gates[..., 1, None] * o_sel + gates[..., 2, None] * o_win
    return o.reshape(B, S, H * DH) @ w_out


def swiglu(x, w_gate, w_up, w_down):
    return (jax.nn.silu(x @ w_gate) * (x @ w_up)) @ w_down


def moe_ffn(x, w_router, w_gate, w_up, w_down):
    B, S, D = x.shape
    xt = x.reshape(B * S, D)
    logits = (xt @ w_router).astype(jnp.float32)
    top_v, top_i = lax.top_k(logits, TOP_K)
    top_w = jax.nn.softmax(top_v, axis=-1)
    gates = jnp.sum(jax.nn.one_hot(top_i, N_EXPERTS, dtype=jnp.float32) * top_w[..., None], axis=1)
    gates = gates.astype(x.dtype)
    out = jnp.zeros_like(xt)
    for e in range(N_EXPERTS):
        out = out + gates[:, e:e + 1] * swiglu(xt, w_gate[e], w_up[e], w_down[e])
    return out.reshape(B, S, D)


def setup_inputs(seed: int = 0) -> dict:
    key = jax.random.key(seed)
    ks = iter(jax.random.split(key, 40))
    n_a = (DEPTH + 1) // 2
    n_b = DEPTH // 2
    f32 = jnp.float32

    def nrm(shape, fan_in):
        return jax.random.normal(next(ks), shape, f32) * (fan_in ** -0.5)

    def small(shape, s=0.02):
        return jax.random.normal(next(ks), shape, f32) * s

    u = jax.random.uniform(next(ks), (n_a, D_RNN), f32, minval=0.9, maxval=0.999)
    s = u ** (1.0 / LRU_C)
    lam = jnp.log(s) - jnp.log1p(-s)
    return {
        "x": jax.random.normal(next(ks), (BATCH, SEQ, D_MODEL), f32),
        "norm_mix": 1.0 + small((DEPTH, D_MODEL), 0.05),
        "norm_ffn": 1.0 + small((DEPTH, D_MODEL), 0.05),
        "norm_final": 1.0 + small((D_MODEL,), 0.05),
        "lru_w_in": nrm((n_a, D_MODEL, 2 * D_RNN), D_MODEL),
        "lru_b_in": small((n_a, 2 * D_RNN)),
        "lru_conv_w": nrm((n_a, CONV_WIDTH, D_RNN), CONV_WIDTH),
        "lru_conv_b": small((n_a, D_RNN)),
        "lru_w_a": nrm((n_a, RNN_BLOCKS, RNN_BW, RNN_BW), RNN_BW),
        "lru_b_a": small((n_a, D_RNN), 0.1),
        "lru_w_i": nrm((n_a, RNN_BLOCKS, RNN_BW, RNN_BW), RNN_BW),
        "lru_b_i": small((n_a, D_RNN), 0.1),
        "lru_lambda": lam,
        "lru_w_out": nrm((n_a, D_RNN, D_MODEL), D_RNN),
        "lru_b_out": small((n_a, D_MODEL)),
        "nsa_w_in": nrm((n_b, D_MODEL, NSA_IN), D_MODEL),
        "nsa_cmp_pe": small((n_b, 2, CMP_BLOCK, HEAD_DIM), 0.1),
        "nsa_cmp_w1": nrm((n_b, 2, CMP_BLOCK * HEAD_DIM, CMP_HIDDEN), CMP_BLOCK * HEAD_DIM),
        "nsa_cmp_w2": nrm((n_b, 2, CMP_HIDDEN, HEAD_DIM), CMP_HIDDEN),
        "nsa_w_out": nrm((n_b, N_HEADS * HEAD_DIM, D_MODEL), N_HEADS * HEAD_DIM),
        "ffn_w_gate": nrm((n_a, D_MODEL, D_FF), D_MODEL),
        "ffn_w_up": nrm((n_a, D_MODEL, D_FF), D_MODEL),
        "ffn_w_down": nrm((n_a, D_FF, D_MODEL), D_FF),
        "moe_w_router": nrm((n_b, D_MODEL, N_EXPERTS), D_MODEL),
        "moe_w_gate": nrm((n_b, N_EXPERTS, D_MODEL, D_FF), D_MODEL),
        "moe_w_up": nrm((n_b, N_EXPERTS, D_MODEL, D_FF), D_MODEL),
        "moe_w_down": nrm((n_b, N_EXPERTS, D_FF, D_MODEL), D_FF),
    }


def reference(x, norm_mix, norm_ffn, norm_final,
              lru_w_in, lru_b_in, lru_conv_w, lru_conv_b, lru_w_a, lru_b_a,
              lru_w_i, lru_b_i, lru_lambda, lru_w_out, lru_b_out,
              nsa_w_in, nsa_cmp_pe, nsa_cmp_w1, nsa_cmp_w2, nsa_w_out,
              ffn_w_gate, ffn_w_up, ffn_w_down,
              moe_w_router, moe_w_gate, moe_w_up, moe_w_down):
    for layer in range(DEPTH):
        j = layer // 2
        h = rmsnorm(x, norm_mix[layer])
        if layer % 2 == 0:
            x = x + rglru_mixer(h, lru_w_in[j], lru_b_in[j], lru_conv_w[j], lru_conv_b[j],
                                lru_w_a[j], lru_b_a[j], lru_w_i[j], lru_b_i[j],
                                lru_lambda[j], lru_w_out[j], lru_b_out[j])
            h = rmsnorm(x, norm_ffn[layer])
            x = x + swiglu(h, ffn_w_gate[j], ffn_w_up[j], ffn_w_down[j])
        else:
            x = x + nsa_mixer(h, nsa_w_in[j], nsa_cmp_pe[j], nsa_cmp_w1[j], nsa_cmp_w2[j],
                              nsa_w_out[j])
            h = rmsnorm(x, norm_ffn[layer])
            x = x + moe_ffn(h, moe_w_router[j], moe_w_gate[j], moe_w_up[j], moe_w_down[j])
    return rmsnorm(x, norm_final)
```

```cpp
#include <hip/hip_runtime.h>
#include <cstdio>
#include <cstdint>
namespace pg8 {
#define PG8_LAS __attribute__((address_space(3)))
typedef unsigned short bf16_t;
typedef short bf16x8 __attribute__((ext_vector_type(8)));
typedef float f32x4 __attribute__((ext_vector_type(4)));
typedef unsigned u32x4 __attribute__((ext_vector_type(4)));
constexpr int BM = 256, BK = 64, HALF = 128, HTB = HALF * BK * 2  , STAGE_BYTES = 8 * HTB, NXCD = 8, WGM = 4;

__host__ __device__ __forceinline__ int lds_byte(int r, int c) { const int st = (r >> 4) * 2 + (c >> 5), rr = r & 15, cc = c & 31, ob = rr * 64 + cc * 2; return st * 1024 + (ob ^ (((ob >> 9) & 1) << 5)); }
__host__ __device__ __forceinline__ void stage_rc(int b, int& R, int& C) { const int st = b / 1024, sb = b % 1024, swz = sb ^ (((sb >> 9) & 1) << 5); R = (st >> 1) * 16 + swz / 64; C = (st & 1) * 32 + (swz % 64) / 2; }
__host__ __device__ __forceinline__ int perm32(int rho) { const int n = rho >> 4, i = rho & 15; return 8 * (i >> 2) + 4 * n + (i & 3); }

struct Unit { int pm, pn; };
struct Gemm { const bf16_t* A; const bf16_t* Bt; int M, N, K, lda, ldb, pad; };

struct StaticOrder {
    int nM, nN, nwg, G, c;
    __host__ __device__ void init(int M, int N, int G_, int c_) { nM = M / BM; nN = N / BM; nwg = nM * nN; G = G_; c = c_; }
    __host__ __device__ bool next(int i, Unit& u) const {
        const long L = (long)i * G + c; if (L >= nwg) return false;
        int wgid = (int)L; { const int q = nwg / NXCD, r = nwg % NXCD, xcd = wgid % NXCD, off = wgid / NXCD; wgid = (xcd < r ? xcd * (q + 1) : r * (q + 1) + (xcd - r) * q) + off; }
        const int nig = WGM * nN, gid = wgid / nig, fm = gid * WGM, gsz = (nM - fm) < WGM ? (nM - fm) : WGM;
        u.pm = fm + ((wgid % nig) % gsz); u.pn = (wgid % nig) / gsz; return true;
    }
    __device__ __forceinline__ void a_ready(const Unit&) const {}
    __device__ __forceinline__ void done(const Unit&) const {}
};

__device__ __forceinline__ unsigned cvt_pk_bf16(float lo, float hi) { unsigned r; asm volatile("v_cvt_pk_bf16_f32 %0, %1, %2" : "=v"(r) : "v"(lo), "v"(hi)); return r; }
__device__ __forceinline__ float gelu_tanh(float x) { const float u = 1.5957691216f * (x + 0.044715f * x * x * x); return x * __builtin_amdgcn_rcpf(1.0f + __expf(-u)); }
__device__ __forceinline__ float silu_f(float x) { return x * __builtin_amdgcn_rcpf(1.0f + __expf(-x)); }

struct EpiBf16G {
    static constexpr bool PERM = true, AFTER_DRAIN = false; static constexpr int NST = 0;
    bf16_t* O; const float* bias; const float* rsv; int ldc; int gelu_cols;
    __device__ __forceinline__ void operator()(const f32x4 (&acc)[2][2][4][2], const Unit& u, int wr, int wc, int fr, int fq) const {
        const int row0 = u.pm * BM + wr * 64 + fr, col0 = u.pn * BM + wc * 32 + 8 * fq;
        f32x4 bv[2][2];
#pragma unroll
        for (int bj = 0; bj < 2; ++bj)
#pragma unroll
            for (int n = 0; n < 2; ++n) bv[bj][n] = bias ? *(const f32x4*)(bias + col0 + bj * HALF + 4 * n) : (f32x4){0.f, 0.f, 0.f, 0.f};
        float rr[2][4];
#pragma unroll
        for (int ai = 0; ai < 2; ++ai)
#pragma unroll
            for (int m = 0; m < 4; ++m) rr[ai][m] = rsv ? rsv[row0 + ai * HALF + m * 16] : 1.0f;
        asm volatile("" ::: "memory");
#pragma unroll
        for (int ai = 0; ai < 2; ++ai)
#pragma unroll
            for (int m = 0; m < 4; ++m) { bf16_t* rowp = O + (size_t)(row0 + ai * HALF + m * 16) * ldc + col0; const float r_ = rr[ai][m];
#pragma unroll
                for (int bj = 0; bj < 2; ++bj) { f32x4 v0 = acc[ai][bj][m][0] * r_ + bv[bj][0], v1 = acc[ai][bj][m][1] * r_ + bv[bj][1];
                    if (u.pn * BM + bj * HALF < gelu_cols) {
                        constexpr float c0 = -1.4426950408889634f * 1.5957691216f, c1 = c0 * 0.044715f;
                        f32x4 t0 = v0 * (v0 * v0 * c1 + c0), t1 = v1 * (v1 * v1 * c1 + c0);
#pragma unroll
                        for (int j = 0; j < 4; ++j) { t0[j] = __builtin_amdgcn_exp2f(t0[j]); t1[j] = __builtin_amdgcn_exp2f(t1[j]); }
                        t0 = t0 + 1.0f; t1 = t1 + 1.0f;
#pragma unroll
                        for (int j = 0; j < 4; ++j) { t0[j] = __builtin_amdgcn_rcpf(t0[j]); t1[j] = __builtin_amdgcn_rcpf(t1[j]); }
                        v0 = v0 * t0; v1 = v1 * t1; }
                    u32x4 w; w.x = cvt_pk_bf16(v0[0], v0[1]); w.y = cvt_pk_bf16(v0[2], v0[3]); w.z = cvt_pk_bf16(v1[0], v1[1]); w.w = cvt_pk_bf16(v1[2], v1[3]);
                    *(u32x4*)(rowp + bj * HALF) = w; } }
    }
};
struct EpiResid {
    static constexpr bool PERM = true, AFTER_DRAIN = false;
    const float* R; float* X; const float* bias; const float* rowscale; int ldc; int rs_stride;
    __device__ __forceinline__ void operator()(const f32x4 (&acc)[2][2][4][2], const Unit& u, int wr, int wc, int fr, int fq) const {
        const int row0 = u.pm * BM + wr * 64 + fr, col0 = u.pn * BM + wc * 32 + 8 * fq;
        f32x4 bv[2][2];
#pragma unroll
        for (int bj = 0; bj < 2; ++bj)
#pragma unroll
            for (int n = 0; n < 2; ++n) bv[bj][n] = bias ? *(const f32x4*)(bias + col0 + bj * HALF + 4 * n) : (f32x4){0.f, 0.f, 0.f, 0.f};
#pragma unroll
        for (int ai = 0; ai < 2; ++ai)
#pragma unroll
            for (int m = 0; m < 4; ++m) { const int row = row0 + ai * HALF + m * 16; const size_t off = (size_t)row * ldc + col0;
                const float rs = rowscale ? rowscale[(size_t)row * rs_stride] : 1.0f;
#pragma unroll
                for (int bj = 0; bj < 2; ++bj)
#pragma unroll
                    for (int n = 0; n < 2; ++n) { const f32x4 r = *(const f32x4*)(R + off + bj * HALF + 4 * n);
                        *(f32x4*)(X + off + bj * HALF + 4 * n) = r + (acc[ai][bj][m][n] + bv[bj][n]) * rs; } }
    }
};

__device__ __forceinline__ void unpack8(const u32x4 p, f32x4& lo, f32x4& hi) {
    lo[0] = __uint_as_float(p.x << 16); lo[1] = __uint_as_float(p.x & 0xffff0000u); lo[2] = __uint_as_float(p.y << 16); lo[3] = __uint_as_float(p.y & 0xffff0000u);
    hi[0] = __uint_as_float(p.z << 16); hi[1] = __uint_as_float(p.z & 0xffff0000u); hi[2] = __uint_as_float(p.w << 16); hi[3] = __uint_as_float(p.w & 0xffff0000u); }
__device__ __forceinline__ u32x4 pack8(const f32x4 lo, const f32x4 hi) { u32x4 w; w.x = cvt_pk_bf16(lo[0], lo[1]); w.y = cvt_pk_bf16(lo[2], lo[3]); w.z = cvt_pk_bf16(hi[0], hi[1]); w.w = cvt_pk_bf16(hi[2], hi[3]); return w; }
template <bool R32> struct EpiResidB {
    static constexpr bool PERM = true, AFTER_DRAIN = false; static constexpr int NST = 0;
    const void* R; bf16_t* X; const float* bias; float* rsq; PG8_LAS float* xch; int ldc;
    __device__ __forceinline__ void operator()(const f32x4 (&acc)[2][2][4][2], const Unit& u, int wr, int wc, int fr, int fq) const {
        const int row0 = u.pm * BM + wr * 64 + fr, col0 = u.pn * BM + wc * 32 + 8 * fq;
        f32x4 bv[2][2];
#pragma unroll
        for (int bj = 0; bj < 2; ++bj)
#pragma unroll
            for (int n = 0; n < 2; ++n) bv[bj][n] = bias ? *(const f32x4*)(bias + col0 + bj * HALF + 4 * n) : (f32x4){0.f, 0.f, 0.f, 0.f};
#pragma unroll
        for (int ai = 0; ai < 2; ++ai) { float ssq[2][4] = {{0.f, 0.f, 0.f, 0.f}, {0.f, 0.f, 0.f, 0.f}};
            if constexpr (R32) {
#pragma unroll
                for (int mp = 0; mp < 2; ++mp) { f32x4 rin[2][2][2];
#pragma unroll
                    for (int mm = 0; mm < 2; ++mm)
#pragma unroll
                        for (int bj = 0; bj < 2; ++bj) { const size_t off = (size_t)(row0 + ai * HALF + (2 * mp + mm) * 16) * ldc + col0 + bj * HALF;
                            rin[mm][bj][0] = *(const f32x4*)((const float*)R + off); rin[mm][bj][1] = *(const f32x4*)((const float*)R + off + 4); }
                    asm volatile("" ::: "memory");
#pragma unroll
                    for (int mm = 0; mm < 2; ++mm)
#pragma unroll
                        for (int bj = 0; bj < 2; ++bj) { const int m = 2 * mp + mm; const size_t off = (size_t)(row0 + ai * HALF + m * 16) * ldc + col0 + bj * HALF;
                            const f32x4 n0 = rin[mm][bj][0] + acc[ai][bj][m][0] + bv[bj][0], n1 = rin[mm][bj][1] + acc[ai][bj][m][1] + bv[bj][1];
                            ssq[ai][m] += (n0[0] * n0[0] + n0[1] * n0[1]) + (n0[2] * n0[2] + n0[3] * n0[3]) + (n1[0] * n1[0] + n1[1] * n1[1]) + (n1[2] * n1[2] + n1[3] * n1[3]);
                            *(u32x4*)(X + off) = pack8(n0, n1); } }
            } else { u32x4 rin[4][2];
#pragma unroll
                for (int m = 0; m < 4; ++m)
#pragma unroll
                    for (int bj = 0; bj < 2; ++bj) rin[m][bj] = *(const u32x4*)((const bf16_t*)R + (size_t)(row0 + ai * HALF + m * 16) * ldc + col0 + bj * HALF);
                asm volatile("" ::: "memory");
#pragma unroll
                for (int m = 0; m < 4; ++m)
#pragma unroll
                    for (int bj = 0; bj < 2; ++bj) { f32x4 r0, r1; unpack8(rin[m][bj], r0, r1);
                        const f32x4 n0 = r0 + acc[ai][bj][m][0] + bv[bj][0], n1 = r1 + acc[ai][bj][m][1] + bv[bj][1];
                        ssq[ai][m] += (n0[0] * n0[0] + n0[1] * n0[1]) + (n0[2] * n0[2] + n0[3] * n0[3]) + (n1[0] * n1[0] + n1[1] * n1[1]) + (n1[2] * n1[2] + n1[3] * n1[3]);
                        *(u32x4*)(X + (size_t)(row0 + ai * HALF + m * 16) * ldc + col0 + bj * HALF) = pack8(n0, n1); } }
            if (rsq) {
#pragma unroll
                for (int m = 0; m < 4; ++m) { float t = ssq[ai][m];
                    { const auto r_ = __builtin_amdgcn_permlane16_swap(__float_as_uint(t), __float_as_uint(t), false, false); t = __uint_as_float(r_[0]) + __uint_as_float(r_[1]); }
                    { const auto r_ = __builtin_amdgcn_permlane32_swap(__float_as_uint(t), __float_as_uint(t), false, false); t = __uint_as_float(r_[0]) + __uint_as_float(r_[1]); }
                    if (fq == 0) xch[(wr * 4 + wc) * 128 + (ai * 4 + m) * 16 + fr] = t; }
            }
        }
        if (rsq) {
            asm volatile("s_waitcnt lgkmcnt(0)" ::: "memory"); __builtin_amdgcn_s_barrier(); asm volatile("" ::: "memory");
            if (fq == 0) {
#pragma unroll
                for (int ai = 0; ai < 2; ++ai) { const int o = (ai * 4 + wc) * 16 + fr;
                    const float t = (xch[(wr * 4 + 0) * 128 + o] + xch[(wr * 4 + 1) * 128 + o]) + (xch[(wr * 4 + 2) * 128 + o] + xch[(wr * 4 + 3) * 128 + o]);
                    rsq[(size_t)(row0 + ai * HALF + wc * 16) * 4 + u.pn] = t; }
            }
        }
    }
};

struct EpiNsa {
    static constexpr bool PERM = true, AFTER_DRAIN = false; static constexpr int NST = 0;
    bf16_t *pQ, *pKC, *pVC, *pKS, *pVS, *pKW, *pVW; float* gates; const float* tab; const float* rsq;
    __device__ __forceinline__ void operator()(const f32x4 (&acc)[2][2][4][2], const Unit& u, int wr, int wc, int fr, int fq) const {
        const int row0 = u.pm * BM + wr * 64 + fr, pn = u.pn;
        if (pn == 10) {
#pragma unroll
            for (int ai = 0; ai < 2; ++ai) { float rs[4];
#pragma unroll
                for (int m = 0; m < 4; ++m) { const f32x4 ps = *(const f32x4*)(rsq + (size_t)(row0 + ai * HALF + m * 16) * 4); rs[m] = (ps[0] + ps[1]) + (ps[2] + ps[3]); }
#pragma unroll
                for (int m = 0; m < 4; ++m) rs[m] = __builtin_amdgcn_rsqf(rs[m] * (1.0f / 1024.0f) + 1e-6f);
#pragma unroll
                for (int m = 0; m < 4; ++m) { const int row = row0 + ai * HALF + m * 16;
#pragma unroll
                    for (int n = 0; n < 2; ++n) { const int c = 32 * wc + 8 * fq + 4 * n;
                        if (c < 48) { f32x4 v = acc[ai][0][m][n] * rs[m];
#pragma unroll
                            for (int j = 0; j < 4; ++j) v[j] = __builtin_amdgcn_rcpf(1.0f + __expf(-v[j]));
                            *(f32x4*)(gates + (size_t)row * 48 + c) = v; } } } }
        } else if (pn < 5 || pn == 6 || pn == 8) {
            bf16_t* kb = (pn == 4) ? pKC : (pn == 6 ? pKS : pKW); const float sc = (pn < 4) ? 0.125f : 1.0f;
#pragma unroll
            for (int ai = 0; ai < 2; ++ai) { float rs[4];
#pragma unroll
                for (int m = 0; m < 4; ++m) { const f32x4 ps = *(const f32x4*)(rsq + (size_t)(row0 + ai * HALF + m * 16) * 4); rs[m] = (ps[0] + ps[1]) + (ps[2] + ps[3]); }
#pragma unroll
                for (int m = 0; m < 4; ++m) rs[m] = __builtin_amdgcn_rsqf(rs[m] * (1.0f / 1024.0f) + 1e-6f);
                f32x4 tv[4][4];
#pragma unroll
                for (int m = 0; m < 4; ++m) { const int t = (row0 + ai * HALF + m * 16) & 8191; const f32x4* tp = (const f32x4*)(tab + ((size_t)t * 32 + 8 * fq) * 2);
                    tv[m][0] = tp[0]; tv[m][1] = tp[1]; tv[m][2] = tp[2]; tv[m][3] = tp[3]; }
                asm volatile("" ::: "memory");
#pragma unroll
                for (int m = 0; m < 4; ++m) { const int row = row0 + ai * HALF + m * 16, t = row & 8191, b = row >> 13;
                    const f32x4 t0 = tv[m][0], t1 = tv[m][1], t2 = tv[m][2], t3 = tv[m][3];
                    const float cs[8] = {t0[0], t0[2], t1[0], t1[2], t2[0], t2[2], t3[0], t3[2]}, sn[8] = {t0[1], t0[3], t1[1], t1[3], t2[1], t2[3], t3[1], t3[3]};
                    float o1[8], o2[8];
#pragma unroll
                    for (int n = 0; n < 2; ++n)
#pragma unroll
                        for (int j = 0; j < 4; ++j) { const float x1 = acc[ai][0][m][n][j], x2 = acc[ai][1][m][n][j], c = cs[4 * n + j], s = sn[4 * n + j], scr_ = sc * rs[m];
                            o1[4 * n + j] = (x1 * c - x2 * s) * scr_; o2[4 * n + j] = (x2 * c + x1 * s) * scr_; }
                    bf16_t* dst = (pn < 4) ? pQ + (size_t)row * 1024 + (4 * pn + wc) * 64 + 8 * fq : kb + ((size_t)(b * 4 + wc) * 8192 + t) * 64 + 8 * fq;
                    u32x4 w1, w2; w1.x = cvt_pk_bf16(o1[0], o1[1]); w1.y = cvt_pk_bf16(o1[2], o1[3]); w1.z = cvt_pk_bf16(o1[4], o1[5]); w1.w = cvt_pk_bf16(o1[6], o1[7]);
                    w2.x = cvt_pk_bf16(o2[0], o2[1]); w2.y = cvt_pk_bf16(o2[2], o2[3]); w2.z = cvt_pk_bf16(o2[4], o2[5]); w2.w = cvt_pk_bf16(o2[6], o2[7]);
                    *(u32x4*)dst = w1; *(u32x4*)(dst + 32) = w2; } }
        } else {
            bf16_t* vb = (pn == 5) ? pVC : (pn == 7 ? pVS : pVW);
#pragma unroll
            for (int ai = 0; ai < 2; ++ai) { float rs[4];
#pragma unroll
                for (int m = 0; m < 4; ++m) { const f32x4 ps = *(const f32x4*)(rsq + (size_t)(row0 + ai * HALF + m * 16) * 4); rs[m] = (ps[0] + ps[1]) + (ps[2] + ps[3]); }
#pragma unroll
                for (int m = 0; m < 4; ++m) rs[m] = __builtin_amdgcn_rsqf(rs[m] * (1.0f / 1024.0f) + 1e-6f);
#pragma unroll
                for (int m = 0; m < 4; ++m) { const int row = row0 + ai * HALF + m * 16, t = row & 8191, b = row >> 13;
#pragma unroll
                    for (int bj = 0; bj < 2; ++bj) { const int g = 2 * bj + (wc >> 1), d = 32 * (wc & 1) + 8 * fq; const f32x4 v0 = acc[ai][bj][m][0] * rs[m], v1 = acc[ai][bj][m][1] * rs[m];
                        u32x4 w; w.x = cvt_pk_bf16(v0[0], v0[1]); w.y = cvt_pk_bf16(v0[2], v0[3]); w.z = cvt_pk_bf16(v1[0], v1[1]); w.w = cvt_pk_bf16(v1[2], v1[3]);
                        *(u32x4*)(vb + ((size_t)(b * 4 + g) * 8192 + t) * 64 + d) = w; } } }
        }
    }
};

struct EpiSwiGLU {
    static constexpr bool PERM = true, AFTER_DRAIN = false; static constexpr int NST = 0;
    bf16_t* H; const float* rsq; int ldc; int pad;
    __device__ __forceinline__ void operator()(const f32x4 (&acc)[2][2][4][2], const Unit& u, int wr, int wc, int fr, int fq) const {
        const int row0 = u.pm * BM + wr * 64 + fr, col0 = u.pn * HALF + wc * 32 + 8 * fq;
#pragma unroll
        for (int ai = 0; ai < 2; ++ai) { float rs[4];
#pragma unroll
            for (int m = 0; m < 4; ++m) { const f32x4 ps = *(const f32x4*)(rsq + (size_t)(row0 + ai * HALF + m * 16) * 4); rs[m] = (ps[0] + ps[1]) + (ps[2] + ps[3]); }
#pragma unroll
            for (int m = 0; m < 4; ++m) rs[m] = rs[m] * (1.0f / 1024.0f) + 1e-6f;
#pragma unroll
            for (int m = 0; m < 4; ++m) { bf16_t* rowp = H + (size_t)(row0 + ai * HALF + m * 16) * ldc + col0; const float q = rs[m], c1 = -1.4426950408889634f * __builtin_amdgcn_rsqf(q);
                f32x4 vv[2];
#pragma unroll
                for (int n = 0; n < 2; ++n) { const f32x4 g = acc[ai][0][m][n], uu = acc[ai][1][m][n]; f32x4 e = g * c1;
                    e[0] = __builtin_amdgcn_exp2f(e[0]); e[1] = __builtin_amdgcn_exp2f(e[1]); e[2] = __builtin_amdgcn_exp2f(e[2]); e[3] = __builtin_amdgcn_exp2f(e[3]);
                    f32x4 d = e * q + q;
                    d[0] = __builtin_amdgcn_rcpf(d[0]); d[1] = __builtin_amdgcn_rcpf(d[1]); d[2] = __builtin_amdgcn_rcpf(d[2]); d[3] = __builtin_amdgcn_rcpf(d[3]);
                    vv[n] = (g * uu) * d; }
                u32x4 w; w.x = cvt_pk_bf16(vv[0][0], vv[0][1]); w.y = cvt_pk_bf16(vv[0][2], vv[0][3]); w.z = cvt_pk_bf16(vv[1][0], vv[1][1]); w.w = cvt_pk_bf16(vv[1][2], vv[1][3]);
                *(u32x4*)rowp = w; } }
    }
};

template <class Epi, class Sched, bool ALIGN_EPI = false, bool SP2 = false>
__device__ __forceinline__ void gemm_phase(PG8_LAS unsigned char* lds, const Gemm g, const Sched& S, const Epi& E) {
    int tid_raw = threadIdx.x; asm volatile("" : "+v"(tid_raw));
    const int tid = tid_raw, wid = __builtin_amdgcn_readfirstlane(tid >> 6), lane = tid & 63, wr = wid >> 2, wc = wid & 3, fr = lane & 15, fq = lane >> 4;
    const int K = g.K, nt = K / BK;
    unsigned voffA[2], voffB[2];
#pragma unroll
    for (int i = 0; i < 2; ++i) { int R, C; stage_rc(tid * 16 + i * 8192, R, C); const int Rb = Epi::PERM ? ((R & ~31) + perm32(R & 31)) : R;
        voffA[i] = (unsigned)(R * g.lda + C) * 2u; voffB[i] = (unsigned)(Rb * g.ldb + C) * 2u; }
    const size_t kstep = (size_t)(BK * 2);
    const size_t hstepA = (size_t)HALF * g.lda * 2, hstepB = (size_t)HALF * g.ldb * 2;
    const size_t tstepA = 2 * hstepA, tstepB = 2 * hstepB;
    const unsigned ldsw = (unsigned)wid * 1024u;
    const int aoff = lds_byte(wr * 64 + fr, fq * 8), boff = lds_byte(wc * 32 + fr, fq * 8);
#define PG8_SA(b, h) (((b) * 2 + (h)) * HTB)
#define PG8_SB(b, h) ((4 + (b) * 2 + (h)) * HTB)
#define PG8_STAGE(bufoff, gbase, voff) do { _Pragma("unroll") for (int _i = 0; _i < 2; ++_i) \
        __builtin_amdgcn_global_load_lds((const unsigned*)((const char*)(gbase) + (voff)[_i]), (PG8_LAS unsigned*)(lds + (bufoff) + ldsw + _i * 8192), 16, 0, 0); } while (0)
#define PG8_LDA(dst, b, h) do { _Pragma("unroll") for (int m = 0; m < 4; ++m) _Pragma("unroll") for (int k = 0; k < 2; ++k) dst[m][k] = *(const PG8_LAS bf16x8*)(lds + PG8_SA(b, h) + aoff + m * 2048 + k * 1024); } while (0)
#define PG8_LDB(dst, b, h) do { _Pragma("unroll") for (int n = 0; n < 2; ++n) _Pragma("unroll") for (int k = 0; k < 2; ++k) dst[n][k] = *(const PG8_LAS bf16x8*)(lds + PG8_SB(b, h) + boff + n * 2048 + k * 1024); } while (0)
#define PG8_MMA(ai, bj, At, Bt) do { __builtin_amdgcn_s_setprio(1); _Pragma("unroll") for (int m = 0; m < 4; ++m) _Pragma("unroll") for (int n = 0; n < 2; ++n) _Pragma("unroll") for (int k = 0; k < 2; ++k) \
        acc[ai][bj][m][n] = __builtin_amdgcn_mfma_f32_16x16x32_bf16(Bt[n][k], At[m][k], acc[ai][bj][m][n], 0, 0, 0); __builtin_amdgcn_s_setprio(0); } while (0)
#define PG8_WAIT_V(n) asm volatile("s_waitcnt vmcnt(" #n ")" ::: "memory")
#define PG8_WAIT_VF(first_) do { if (first_) asm volatile("s_waitcnt vmcnt(%0)" :: "n"(8 + Epi::NST) : "memory"); else asm volatile("s_waitcnt vmcnt(8)" ::: "memory"); } while (0)
#define PG8_WAIT_L(n) asm volatile("s_waitcnt lgkmcnt(" #n ")" ::: "memory")
#define PG8_BAR __builtin_amdgcn_s_barrier()
#define PG8_SCHED __builtin_amdgcn_sched_barrier(0)
    Unit cur, nxt; int ui = 0;
    if (!S.next(0, cur)) return;
    f32x4 acc[2][2][4][2];
#pragma unroll
    for (int a = 0; a < 2; ++a)
#pragma unroll
        for (int b = 0; b < 2; ++b)
#pragma unroll
            for (int m = 0; m < 4; ++m)
#pragma unroll
                for (int n = 0; n < 2; ++n) acc[a][b][m][n] = (f32x4){0.f, 0.f, 0.f, 0.f};
    bf16x8 At[4][2], B0[2][2], B1[2][2];
    const char* cA = (const char*)g.A + (size_t)cur.pm * tstepA; const char* cB = (const char*)g.Bt + (size_t)cur.pn * tstepB;
    S.a_ready(cur);
    if constexpr (SP2) {
        PG8_STAGE(PG8_SB(0, 0), cB, voffB); PG8_STAGE(PG8_SB(0, 1), cB + hstepB, voffB); PG8_STAGE(PG8_SA(0, 0), cA, voffA); PG8_STAGE(PG8_SA(0, 1), cA + hstepA, voffA);
        if (wr == 1) PG8_BAR;
        PG8_WAIT_V(2); PG8_BAR;
        PG8_STAGE(PG8_SB(1, 0), cB + kstep, voffB); PG8_STAGE(PG8_SA(1, 0), cA + kstep, voffA); PG8_STAGE(PG8_SB(1, 1), cB + hstepB + kstep, voffB);
        PG8_WAIT_V(6); PG8_BAR;
    } else {
        PG8_STAGE(PG8_SB(0, 0), cB, voffB); PG8_STAGE(PG8_SA(0, 0), cA, voffA); PG8_STAGE(PG8_SB(0, 1), cB + hstepB, voffB); PG8_STAGE(PG8_SA(0, 1), cA + hstepA, voffA);
        if (wr == 1) PG8_BAR;
        PG8_WAIT_V(4); PG8_BAR;
        PG8_STAGE(PG8_SB(1, 0), cB + kstep, voffB); PG8_STAGE(PG8_SA(1, 0), cA + kstep, voffA); PG8_STAGE(PG8_SB(1, 1), cB + hstepB + kstep, voffB);
        PG8_WAIT_V(6); PG8_BAR;
    }
    for (;;) {
        const bool has_next = S.next(ui + 1, nxt);
        const char* nA = has_next ? (const char*)g.A + (size_t)nxt.pm * tstepA : cA; const char* nB = has_next ? (const char*)g.Bt + (size_t)nxt.pn * tstepB : cB;
        for (int t = 0; t < nt; t += 2) {
            const bool last = (t == nt - 2);
            const char* a1 = cA + (size_t)(t + 1) * kstep;
            const char* a2 = last ? nA : cA + (size_t)(t + 2) * kstep; const char* b2 = last ? nB : cB + (size_t)(t + 2) * kstep;
            const char* a3 = a2 + kstep; const char* b3 = b2 + kstep;
            if (last && has_next) S.a_ready(nxt);
            if constexpr (SP2) {
            const bool firstk = (t == 0) && (ui > 0) && (Epi::NST > 0);
            PG8_LDB(B0, 0, 0); PG8_LDB(B1, 0, 1); PG8_SCHED; PG8_LDA(At, 0, 0); PG8_STAGE(PG8_SA(1, 1), a1 + hstepA, voffA);
            PG8_WAIT_VF(firstk); PG8_WAIT_L(0); PG8_BAR; PG8_MMA(0, 0, At, B0); PG8_MMA(0, 1, At, B1); PG8_BAR; PG8_SCHED;
            PG8_LDA(At, 0, 1); PG8_STAGE(PG8_SB(0, 0), b2, voffB); PG8_STAGE(PG8_SB(0, 1), b2 + hstepB, voffB); PG8_STAGE(PG8_SA(0, 0), a2, voffA);
            PG8_WAIT_VF(firstk); PG8_WAIT_L(0); PG8_BAR; PG8_MMA(1, 0, At, B0); PG8_MMA(1, 1, At, B1); PG8_BAR; PG8_SCHED;
            PG8_LDB(B0, 1, 0); PG8_LDB(B1, 1, 1); PG8_SCHED; PG8_LDA(At, 1, 0); PG8_STAGE(PG8_SA(0, 1), a2 + hstepA, voffA);
            PG8_WAIT_V(8); PG8_WAIT_L(0); PG8_BAR; PG8_MMA(0, 0, At, B0); PG8_MMA(0, 1, At, B1); PG8_BAR; PG8_SCHED;
            PG8_LDA(At, 1, 1); PG8_STAGE(PG8_SB(1, 0), b3, voffB); PG8_STAGE(PG8_SB(1, 1), b3 + hstepB, voffB); PG8_STAGE(PG8_SA(1, 0), a3, voffA);
            PG8_WAIT_V(8); PG8_WAIT_L(0); PG8_BAR; PG8_MMA(1, 0, At, B0); PG8_MMA(1, 1, At, B1); PG8_BAR; PG8_SCHED;
            } else {
            PG8_LDB(B0, 0, 0); PG8_SCHED; PG8_LDA(At, 0, 0); PG8_STAGE(PG8_SA(1, 1), a1 + hstepA, voffA);
            PG8_WAIT_L(8); PG8_BAR; PG8_WAIT_L(0); PG8_MMA(0, 0, At, B0); PG8_BAR; PG8_SCHED;
            PG8_LDB(B1, 0, 1); PG8_STAGE(PG8_SB(0, 0), b2, voffB);
            PG8_BAR; PG8_WAIT_L(0); PG8_MMA(0, 1, At, B1); PG8_BAR;
            PG8_LDA(At, 0, 1); PG8_STAGE(PG8_SA(0, 0), a2, voffA);
            PG8_BAR; PG8_WAIT_L(0); PG8_MMA(1, 0, At, B0); PG8_BAR; PG8_SCHED;
            PG8_STAGE(PG8_SB(0, 1), b2 + hstepB, voffB);
            PG8_WAIT_V(6); PG8_BAR; PG8_MMA(1, 1, At, B1); PG8_BAR;
            PG8_LDB(B0, 1, 0); PG8_SCHED; PG8_LDA(At, 1, 0); PG8_STAGE(PG8_SA(0, 1), a2 + hstepA, voffA);
            PG8_WAIT_L(8); PG8_BAR; PG8_WAIT_L(0); PG8_MMA(0, 0, At, B0); PG8_BAR; PG8_SCHED;
            PG8_LDB(B1, 1, 1); PG8_STAGE(PG8_SB(1, 0), b3, voffB);
            PG8_BAR; PG8_WAIT_L(0); PG8_MMA(0, 1, At, B1); PG8_BAR;
            PG8_LDA(At, 1, 1); PG8_STAGE(PG8_SA(1, 0), a3, voffA);
            PG8_BAR; PG8_WAIT_L(0); PG8_MMA(1, 0, At, B0); PG8_BAR; PG8_SCHED;
            PG8_STAGE(PG8_SB(1, 1), b3 + hstepB, voffB);
            PG8_WAIT_V(6); PG8_BAR; PG8_MMA(1, 1, At, B1); PG8_BAR;
            }
        }
        if constexpr (ALIGN_EPI) { if (wr == 0) PG8_BAR; }
        if constexpr (!Epi::AFTER_DRAIN) { E(acc, cur, wr, wc, fr, fq); S.done(cur); }
        if (!has_next) break;
#pragma unroll
        for (int a = 0; a < 2; ++a)
#pragma unroll
            for (int b = 0; b < 2; ++b)
#pragma unroll
                for (int m = 0; m < 4; ++m)
#pragma unroll
                    for (int n = 0; n < 2; ++n) acc[a][b][m][n] = (f32x4){0.f, 0.f, 0.f, 0.f};
        cur = nxt; cA = nA; cB = nB; ++ui;
        if constexpr (ALIGN_EPI) { if (wr == 1) PG8_BAR; }
    }
    PG8_WAIT_V(0);
    if constexpr (!ALIGN_EPI) { if (wr == 0) PG8_BAR; }
    PG8_BAR;
    if constexpr (Epi::AFTER_DRAIN) { E.fused(acc, cur, wr, wc, fr, fq, lds, wid, lane); S.done(cur); }
#undef PG8_SA
#undef PG8_SB
#undef PG8_STAGE
#undef PG8_LDA
#undef PG8_LDB
#undef PG8_MMA
#undef PG8_WAIT_V
#undef PG8_WAIT_VF
#undef PG8_WAIT_L
#undef PG8_BAR
#undef PG8_SCHED
}

typedef int v8i_t __attribute__((ext_vector_type(8)));
typedef int v4i_t __attribute__((ext_vector_type(4)));
__device__ __forceinline__ v8i_t cat8(const bf16x8& lo, const bf16x8& hi) { const v4i_t a = __builtin_bit_cast(v4i_t, lo), b = __builtin_bit_cast(v4i_t, hi); return (v8i_t){a[0], a[1], a[2], a[3], b[0], b[1], b[2], b[3]}; }
__device__ __forceinline__ float cl8(float x) { return fminf(fmaxf(x, -448.0f), 448.0f); }
__device__ __forceinline__ unsigned pk_fp8x4(float a, float b, float c, float d) { int w = __builtin_amdgcn_cvt_pk_fp8_f32(cl8(a), cl8(b), 0, false); w = __builtin_amdgcn_cvt_pk_fp8_f32(cl8(c), cl8(d), w, true); return (unsigned)w; }
__device__ __forceinline__ unsigned pk_fp8x4m(float a, float b, float c, float d) { int w = __builtin_amdgcn_cvt_pk_fp8_f32(__builtin_amdgcn_fmed3f(a, -448.0f, 448.0f), __builtin_amdgcn_fmed3f(b, -448.0f, 448.0f), 0, false);
    w = __builtin_amdgcn_cvt_pk_fp8_f32(__builtin_amdgcn_fmed3f(c, -448.0f, 448.0f), __builtin_amdgcn_fmed3f(d, -448.0f, 448.0f), w, true); return (unsigned)w; }
struct Unit2 { int pm, pn, l, j, nv, e; };
struct MoeSched {
    const int* idx; const PG8_LAS unsigned* tt; int cap, pass, nN, t0, ntile, jb, je, step;
    __device__ __forceinline__ void init(const PG8_LAS unsigned* tt_, const int* idx_, int cap_, int pass_, int nN_, int t0_, int ntile_, int jb_, int je_, int step_) {
        idx = idx_; tt = tt_; cap = cap_; pass = pass_; nN = nN_; t0 = t0_; ntile = ntile_; jb = jb_; je = je_; step = step_; }
    __device__ __forceinline__ bool next(int i, Unit2& u) const {
        const int L = jb + i * step; if (L >= je) return false;
        u.pm = L % ntile; u.pn = L / ntile; const unsigned w = (unsigned)__builtin_amdgcn_readfirstlane((int)tt[t0 + u.pm]);
        u.e = (int)(w >> 20); u.l = pass * 8 + u.e; u.j = (int)((w >> 10) & 1023u); u.nv = (int)(w & 1023u); return true;
    }
    __device__ __forceinline__ const int* rowp(const Unit2& u, int r) const { const int rc = r < u.nv ? r : u.nv - 1; return idx + (size_t)u.l * cap + 256 * u.j + rc; }
    __device__ __forceinline__ int row(const Unit2& u, int r) const { const int rc = r < u.nv ? r : u.nv - 1; return idx[(size_t)u.l * cap + 256 * u.j + rc]; }
};
__device__ __forceinline__ void moe_build_table(PG8_LAS unsigned* tt, const int* cnt, int pass) {
    if (threadIdx.x == 0) { int n = 0;
        for (int e = 0; e < 8; ++e) { const int ce = cnt[pass * 8 + e]; for (int j = 0; 256 * j < ce; ++j) { const int rem = ce - 256 * j; tt[n++] = ((unsigned)e << 20) | ((unsigned)j << 10) | (unsigned)(rem < 256 ? rem : 256); } }
        tt[255] = (unsigned)n; }
}
template <class Epi, bool GATHER, bool F8 = false>
__device__ __forceinline__ void gemm_phase2(PG8_LAS unsigned char* lds, const bf16_t* A, int lda, const bf16_t* Bt, const bf16_t* Bt7, int ldb, size_t bexp, int K, const MoeSched& S, const Epi& E) {
    int tid_raw = threadIdx.x; asm volatile("" : "+v"(tid_raw));
    const int tid = tid_raw, wid = __builtin_amdgcn_readfirstlane(tid >> 6), lane = tid & 63, wr = wid >> 2, wc = wid & 3, fr = lane & 15, fq = lane >> 4;
    const int nt = K / BK;
    int Rst[2], Cst[2]; unsigned voffB[2];
#pragma unroll
    for (int i = 0; i < 2; ++i) { int R, C; stage_rc(tid * 16 + i * 8192, R, C); const int Rb = Epi::PERM ? ((R & ~31) + perm32(R & 31)) : R; Rst[i] = R; Cst[i] = C; voffB[i] = (unsigned)(Rb * ldb + C) * 2u; }
    const size_t kstep = (size_t)(BK * 2);
    const size_t hstepB = (size_t)HALF * ldb * 2, tstepB = 2 * hstepB, tstepA = (size_t)BM * lda * 2;
    const unsigned ldsw = (unsigned)wid * 1024u;
    const int aoff = lds_byte(wr * 64 + fr, fq * 8), boff = lds_byte(wc * 32 + fr, fq * 8);
#define PG8_SA(b, h) (((b) * 2 + (h)) * HTB)
#define PG8_SB(b, h) ((4 + (b) * 2 + (h)) * HTB)
#define PG8_STAGE(bufoff, gbase, voff) do { _Pragma("unroll") for (int _i = 0; _i < 2; ++_i) \
        __builtin_amdgcn_global_load_lds((const unsigned*)((const char*)(gbase) + (voff)[_i]), (PG8_LAS unsigned*)(lds + (bufoff) + ldsw + _i * 8192), 16, 0, 0); } while (0)
#define PG8_LD8(dst_, base_) do { const v4i_t lo_ = *(const PG8_LAS v4i_t*)(base_), hi_ = *(const PG8_LAS v4i_t*)((base_) + 1024); dst_ = __builtin_shufflevector(lo_, hi_, 0, 1, 2, 3, 4, 5, 6, 7); } while (0)
#define PG8_LDA(dst, b, h) do { _Pragma("unroll") for (int m = 0; m < 4; ++m) { if constexpr (F8) PG8_LD8(dst##8[m], lds + PG8_SA(b, h) + aoff + m * 2048); \
        else { _Pragma("unroll") for (int k = 0; k < 2; ++k) dst[m][k] = *(const PG8_LAS bf16x8*)(lds + PG8_SA(b, h) + aoff + m * 2048 + k * 1024); } } } while (0)
#define PG8_LDB(dst, b, h) do { _Pragma("unroll") for (int n = 0; n < 2; ++n) { if constexpr (F8) PG8_LD8(dst##8[n], lds + PG8_SB(b, h) + boff + n * 2048); \
        else { _Pragma("unroll") for (int k = 0; k < 2; ++k) dst[n][k] = *(const PG8_LAS bf16x8*)(lds + PG8_SB(b, h) + boff + n * 2048 + k * 1024); } } } while (0)
#define PG8_MMA(ai, bj, At, Bt) do { __builtin_amdgcn_s_setprio(1); _Pragma("unroll") for (int m = 0; m < 4; ++m) _Pragma("unroll") for (int n = 0; n < 2; ++n) { \
        if constexpr (F8) { asm volatile("v_mfma_scale_f32_16x16x128_f8f6f4 %0, %1, %2, %0, %3, %3 op_sel_hi:[0,0,0]" : "+v"(acc[ai][bj][m][n]) : "v"(Bt##8[n]), "v"(At##8[m]), "v"(scl8)); } \
        else { _Pragma("unroll") for (int k = 0; k < 2; ++k) acc[ai][bj][m][n] = __builtin_amdgcn_mfma_f32_16x16x32_bf16(Bt[n][k], At[m][k], acc[ai][bj][m][n], 0, 0, 0); } } \
        __builtin_amdgcn_s_setprio(0); } while (0)
#define PG8_WAIT_V(n) asm volatile("s_waitcnt vmcnt(" #n ")" ::: "memory")
#define PG8_WAIT_VF(first_) do { if (first_) asm volatile("s_waitcnt vmcnt(%0)" :: "n"(8 + Epi::NST) : "memory"); else asm volatile("s_waitcnt vmcnt(8)" ::: "memory"); } while (0)
#define PG8_WAIT_L(n) asm volatile("s_waitcnt lgkmcnt(" #n ")" ::: "memory")
#define PG8_BAR __builtin_amdgcn_s_barrier()
#define PG8_SCHED __builtin_amdgcn_sched_barrier(0)
#define PG8_AOFFS(dst, u) do { _Pragma("unroll") for (int _h = 0; _h < 2; ++_h) _Pragma("unroll") for (int _i = 0; _i < 2; ++_i) { const int _r = _h * HALF + Rst[_i]; \
        const int _row = GATHER ? S.row((u), _r) : _r; dst[_h][_i] = (unsigned)(_row * lda + Cst[_i]) * 2u; } } while (0)
    Unit2 cur, nxt; int ui = 0;
    if (!S.next(0, cur)) return;
    f32x4 acc[2][2][4][2];
#pragma unroll
    for (int a = 0; a < 2; ++a)
#pragma unroll
        for (int b = 0; b < 2; ++b)
#pragma unroll
            for (int m = 0; m < 4; ++m)
#pragma unroll
                for (int n = 0; n < 2; ++n) acc[a][b][m][n] = (f32x4){0.f, 0.f, 0.f, 0.f};
    bf16x8 At[4][2], B0[2][2], B1[2][2]; v8i_t At8[4], B08[2], B18[2];
    int scl8 = 0x7f7f7f7f; asm volatile("" : "+v"(scl8));
    unsigned cvo[2][2], nvo[2][2];
    PG8_AOFFS(cvo, cur);
    const char* cA = GATHER ? (const char*)A : (const char*)A + (size_t)cur.pm * tstepA;
    const char* cB = (cur.e == 7 ? (const char*)Bt7 : (const char*)Bt + (size_t)cur.e * bexp) + (size_t)cur.pn * tstepB;
    PG8_STAGE(PG8_SB(0, 0), cB, voffB); PG8_STAGE(PG8_SB(0, 1), cB + hstepB, voffB); PG8_STAGE(PG8_SA(0, 0), cA, cvo[0]); PG8_STAGE(PG8_SA(0, 1), cA, cvo[1]);
    if (wr == 1) PG8_BAR;
    PG8_WAIT_V(2); PG8_BAR;
    PG8_STAGE(PG8_SB(1, 0), cB + kstep, voffB); PG8_STAGE(PG8_SA(1, 0), cA + kstep, cvo[0]); PG8_STAGE(PG8_SB(1, 1), cB + hstepB + kstep, voffB);
    PG8_WAIT_V(6); PG8_BAR;
    Unit2 nn; bool has_next = S.next(1, nxt), has_nn = false;
    if (has_next) { PG8_AOFFS(nvo, nxt); }
    else {
#pragma unroll
        for (int h = 0; h < 2; ++h)
#pragma unroll
            for (int i = 0; i < 2; ++i) nvo[h][i] = cvo[h][i];
    }
    for (;;) {
        const char* nA = cA; const char* nB = cB;
        if (has_next) { nA = GATHER ? (const char*)A : (const char*)A + (size_t)nxt.pm * tstepA; nB = (nxt.e == 7 ? (const char*)Bt7 : (const char*)Bt + (size_t)nxt.e * bexp) + (size_t)nxt.pn * tstepB; }
        for (int t = 0; t < nt; t += 2) {
            const bool last = (t == nt - 2);
            const char* a1 = cA + (size_t)(t + 1) * kstep;
            const char* a2 = last ? nA : cA + (size_t)(t + 2) * kstep; const char* b2 = last ? nB : cB + (size_t)(t + 2) * kstep;
            const char* a3 = a2 + kstep; const char* b3 = b2 + kstep;
            unsigned v2[2][2];
#pragma unroll
            for (int h = 0; h < 2; ++h)
#pragma unroll
                for (int i = 0; i < 2; ++i) v2[h][i] = last ? nvo[h][i] : cvo[h][i];
            const bool firstk = (t == 0) && (ui > 0) && (Epi::NST > 0);
            PG8_LDB(B0, 0, 0); PG8_LDB(B1, 0, 1); PG8_SCHED; PG8_LDA(At, 0, 0); PG8_STAGE(PG8_SA(1, 1), a1, cvo[1]);
            PG8_WAIT_VF(firstk); PG8_WAIT_L(0); PG8_BAR; PG8_MMA(0, 0, At, B0); PG8_MMA(0, 1, At, B1); PG8_BAR; PG8_SCHED;
            PG8_LDA(At, 0, 1); PG8_STAGE(PG8_SB(0, 0), b2, voffB); PG8_STAGE(PG8_SB(0, 1), b2 + hstepB, voffB); PG8_STAGE(PG8_SA(0, 0), a2, v2[0]);
            PG8_WAIT_VF(firstk); PG8_WAIT_L(0); PG8_BAR; PG8_MMA(1, 0, At, B0); PG8_MMA(1, 1, At, B1); PG8_BAR; PG8_SCHED;
            PG8_LDB(B0, 1, 0); PG8_LDB(B1, 1, 1); PG8_SCHED; PG8_LDA(At, 1, 0); PG8_STAGE(PG8_SA(0, 1), a2, v2[1]);
            PG8_WAIT_V(8); PG8_WAIT_L(0); PG8_BAR; PG8_MMA(0, 0, At, B0); PG8_MMA(0, 1, At, B1); PG8_BAR; PG8_SCHED;
            PG8_LDA(At, 1, 1); PG8_STAGE(PG8_SB(1, 0), b3, voffB); PG8_STAGE(PG8_SB(1, 1), b3 + hstepB, voffB); PG8_STAGE(PG8_SA(1, 0), a3, v2[0]);
            PG8_WAIT_V(8); PG8_WAIT_L(0); PG8_BAR; PG8_MMA(1, 0, At, B0); PG8_MMA(1, 1, At, B1); PG8_BAR; PG8_SCHED;
        }
        int nr[2][2];
        has_nn = has_next && S.next(ui + 2, nn);
        if (!has_nn) nn = cur;
        if constexpr (GATHER) {
#pragma unroll
            for (int h = 0; h < 2; ++h)
#pragma unroll
                for (int i = 0; i < 2; ++i) { const int* ip = S.rowp(nn, h * HALF + Rst[i]); asm volatile("global_load_dword %0, %1, off" : "=&v"(nr[h][i]) : "v"(ip) : "memory"); }
        }
        if (wr == 0) PG8_BAR;
        if constexpr (F8) asm volatile("s_nop 7\n\ts_nop 7\n\ts_nop 7\n\ts_nop 7" ::: "memory");
        E(acc, cur, wr, wc, fr, fq);
        if constexpr (GATHER) asm volatile("s_waitcnt vmcnt(%4)" : "+v"(nr[0][0]), "+v"(nr[0][1]), "+v"(nr[1][0]), "+v"(nr[1][1]) : "n"(Epi::NST) : "memory");
        if (!has_next) break;
#pragma unroll
        for (int a = 0; a < 2; ++a)
#pragma unroll
            for (int b = 0; b < 2; ++b)
#pragma unroll
                for (int m = 0; m < 4; ++m)
#pragma unroll
                    for (int n = 0; n < 2; ++n) acc[a][b][m][n] = (f32x4){0.f, 0.f, 0.f, 0.f};
        cur = nxt; cA = nA; cB = nB; ++ui;
#pragma unroll
        for (int h = 0; h < 2; ++h)
#pragma unroll
            for (int i = 0; i < 2; ++i) cvo[h][i] = nvo[h][i];
        nxt = nn; has_next = has_nn;
        if (has_next) {
#pragma unroll
            for (int h = 0; h < 2; ++h)
#pragma unroll
                for (int i = 0; i < 2; ++i) { const int row_ = GATHER ? nr[h][i] : h * HALF + Rst[i]; nvo[h][i] = (unsigned)(row_ * lda + Cst[i]) * 2u; }
        }
        if (wr == 1) PG8_BAR;
    }
    PG8_WAIT_V(0);
    PG8_BAR;
#undef PG8_AOFFS
#undef PG8_SA
#undef PG8_SB
#undef PG8_STAGE
#undef PG8_LDA
#undef PG8_LD8
#undef PG8_LDB
#undef PG8_MMA
#undef PG8_WAIT_V
#undef PG8_WAIT_VF
#undef PG8_WAIT_L
#undef PG8_BAR
#undef PG8_SCHED
}
struct EpiSwiGLU2 {
    static constexpr bool PERM = true, AFTER_DRAIN = false; static constexpr int NST = 0;
    bf16_t* H; int ldc; int pad;
    __device__ __forceinline__ void operator()(const f32x4 (&acc)[2][2][4][2], const Unit2& u, int wr, int wc, int fr, int fq) const {
        const int row0 = u.pm * BM + wr * 64 + fr, col0 = u.pn * HALF + wc * 32 + 8 * fq;
#pragma unroll
        for (int ai = 0; ai < 2; ++ai)
#pragma unroll
            for (int m = 0; m < 4; ++m) { bf16_t* rowp = H + (size_t)(row0 + ai * HALF + m * 16) * ldc + col0;
                f32x4 v0, v1;
#pragma unroll
                for (int j = 0; j < 4; ++j) { v0[j] = silu_f(acc[ai][0][m][0][j]) * acc[ai][1][m][0][j]; v1[j] = silu_f(acc[ai][0][m][1][j]) * acc[ai][1][m][1][j]; }
                u32x4 w; w.x = cvt_pk_bf16(v0[0], v0[1]); w.y = cvt_pk_bf16(v0[2], v0[3]); w.z = cvt_pk_bf16(v1[0], v1[1]); w.w = cvt_pk_bf16(v1[2], v1[3]);
                *(u32x4*)rowp = w; }
    }
};
struct EpiSwiGLU2F8 {
    static constexpr bool PERM = true, AFTER_DRAIN = false; static constexpr int NST = 8;
    unsigned char* H; int ldc; float inv, oscale; int pad;
    __device__ __forceinline__ void operator()(const f32x4 (&acc)[2][2][4][2], const Unit2& u, int wr, int wc, int fr, int fq) const {
        const int row0 = u.pm * BM + wr * 64 + fr, col0 = u.pn * HALF + wc * 32 + 8 * fq;
        const float ne = -1.4426950408889634f * inv, kinv = 1.0f / (inv * inv * oscale);
#pragma unroll
        for (int ai = 0; ai < 2; ++ai)
#pragma unroll
            for (int m = 0; m < 4; ++m) { unsigned char* rowp = H + (size_t)(row0 + ai * HALF + m * 16) * ldc + col0;
                f32x4 vv[2];
#pragma unroll
                for (int n = 0; n < 2; ++n) { const f32x4 g = acc[ai][0][m][n], uu = acc[ai][1][m][n]; f32x4 e = g * ne;
                    e[0] = __builtin_amdgcn_exp2f(e[0]); e[1] = __builtin_amdgcn_exp2f(e[1]); e[2] = __builtin_amdgcn_exp2f(e[2]); e[3] = __builtin_amdgcn_exp2f(e[3]);
                    f32x4 d = e * kinv + kinv;
                    d[0] = __builtin_amdgcn_rcpf(d[0]); d[1] = __builtin_amdgcn_rcpf(d[1]); d[2] = __builtin_amdgcn_rcpf(d[2]); d[3] = __builtin_amdgcn_rcpf(d[3]);
                    vv[n] = (g * uu) * d; }
                uint2 w; w.x = pk_fp8x4m(vv[0][0], vv[0][1], vv[0][2], vv[0][3]); w.y = pk_fp8x4m(vv[1][0], vv[1][1], vv[1][2], vv[1][3]);
                *(uint2*)rowp = w; }
    }
};
struct EpiMoeDown {
    static constexpr bool PERM = true, AFTER_DRAIN = false; static constexpr int NST = 0;
    bf16_t* X; const int* idx; const float* wrow; int ldc; int cap; float inv; int pad;
    __device__ __forceinline__ void operator()(const f32x4 (&acc)[2][2][4][2], const Unit2& u, int wr, int wc, int fr, int fq) const {
        const int r0 = wr * 64 + fr, col0 = u.pn * BM + wc * 32 + 8 * fq;
#pragma unroll
        for (int ai = 0; ai < 2; ++ai) { int tok[4]; float wv[4]; u32x4 xin[4][2];
#pragma unroll
            for (int m = 0; m < 4; ++m) { const int r = r0 + ai * HALF + m * 16, rc = r < u.nv ? r : u.nv - 1; const size_t li = (size_t)u.l * cap + 256 * u.j + rc; tok[m] = idx[li]; wv[m] = wrow[li] * inv; }
#pragma unroll
            for (int m = 0; m < 4; ++m)
#pragma unroll
                for (int bj = 0; bj < 2; ++bj) xin[m][bj] = *(const u32x4*)(X + (size_t)tok[m] * ldc + col0 + bj * HALF);
#pragma unroll
            for (int m = 0; m < 4; ++m) { const int r = r0 + ai * HALF + m * 16;
                if (r < u.nv) { bf16_t* xp = X + (size_t)tok[m] * ldc + col0;
#pragma unroll
                    for (int bj = 0; bj < 2; ++bj) { f32x4 r0v, r1v; unpack8(xin[m][bj], r0v, r1v); *(u32x4*)(xp + bj * HALF) = pack8(r0v + acc[ai][bj][m][0] * wv[m], r1v + acc[ai][bj][m][1] * wv[m]); } } } }
    }
};

}

typedef unsigned short bf16;
#define LAS __attribute__((address_space(3)))
typedef float f32x4 __attribute__((ext_vector_type(4)));
typedef float f32x2 __attribute__((ext_vector_type(2)));
constexpr int NB_ = 4, S_ = 8192, T_ = NB_ * S_, D_ = 1024, DR_ = 1408, NBLK_ = 16, BW_ = 88, FF_ = 3584, NE_ = 8;
constexpr int NH_ = 16, DH_ = 64, NG_ = 4, NSA_IN_ = 2608, NSA_PAD_ = 2816, NCMP_ = 512  ;
constexpr float EPS_ = 1e-6f;
constexpr int NTHR = 512, NWAVE = 8;

__device__ __forceinline__ float bf2f(bf16 b) { return __uint_as_float((unsigned)b << 16); }
__device__ __forceinline__ bf16 f2bf(float f) { unsigned u = __float_as_uint(f); return (bf16)((u + 0x7fffu + ((u >> 16) & 1u)) >> 16); }
__device__ __forceinline__ float wave_sum(float v) {
#pragma unroll
    for (int o = 1; o < 64; o <<= 1) v += __shfl_xor(v, o);
    return v;
}
__device__ __forceinline__ float wave_max(float v) {
#pragma unroll
    for (int o = 1; o < 64; o <<= 1) v = fmaxf(v, __shfl_xor(v, o));
    return v;
}
__device__ __forceinline__ int otid() { int t = threadIdx.x; asm volatile("" : "+v"(t)); return t; }
#define WAVE_LDS_SYNC() do { asm volatile("s_waitcnt lgkmcnt(0)" ::: "memory"); __builtin_amdgcn_wave_barrier(); } while (0)

template <bool F8 = false>
__device__ __forceinline__ void convT_job(LAS float* scr  , const float* __restrict__ src, bf16* __restrict__ dst, int K, int N, int Npad, int dst_ld, int dst_koff, int blk, int blk_stride, int row_off,
                                          int G, int bid, float f8scale = 1.0f, const float* __restrict__ kgain = nullptr) {
    const int tid_ = otid(); const int half = tid_ >> 8, t = tid_ & 255, lr = t >> 4, lc4 = t & 15, wn = t >> 2, wk = t & 3;
    const int ncx = (Npad + 63) / 64, ntile = ncx * (K / 64);
    LAS float* tile = scr + half * (64 * 65);
    f32x4 v[4];
    int ti = bid * 2 + half;
    if (ti < ntile) { const int c = (ti % ncx) * 64 + 4 * lc4, k0 = (ti / ncx) * 64;
#pragma unroll
        for (int i = 0; i < 4; ++i) v[i] = (c < N) ? *(const f32x4*)(src + (size_t)(k0 + lr + 16 * i) * N + c) : (f32x4){0.f, 0.f, 0.f, 0.f}; }
    for (int base = bid * 2; base < ntile; base += 2 * G) {
        ti = base + half; const bool ok = ti < ntile; const int c0 = (ti % ncx) * 64, k0 = (ti / ncx) * 64;
        if (ok) {
#pragma unroll
            for (int i = 0; i < 4; ++i)
#pragma unroll
                for (int j = 0; j < 4; ++j) tile[(lr + 16 * i) * 65 + 4 * lc4 + j] = v[i][j];
        }
        const int tn = ti + 2 * G;
        if (tn < ntile) { const int c = (tn % ncx) * 64 + 4 * lc4, kn = (tn / ncx) * 64;
#pragma unroll
            for (int i = 0; i < 4; ++i) v[i] = (c < N) ? *(const f32x4*)(src + (size_t)(kn + lr + 16 * i) * N + c) : (f32x4){0.f, 0.f, 0.f, 0.f}; }
        asm volatile("s_waitcnt lgkmcnt(0)" ::: "memory"); __builtin_amdgcn_s_barrier(); asm volatile("" ::: "memory");
        if (ok) { const int c = c0 + wn;
            if (c < Npad) { int r; if (blk < 0) { const int pnn = c >> 8; const bool rp = (pnn < 5) || pnn == 6 || pnn == 8; r = rp ? (pnn * 256 + 128 * ((c & 63) >> 5) + 32 * ((c & 255) >> 6) + (c & 31)) : c; }
                else r = (c / blk) * blk_stride + (c % blk) + row_off;
                if constexpr (F8) { unsigned w[4];
#pragma unroll
                    for (int j = 0; j < 4; ++j) { const float a0 = tile[(16 * wk + 4 * j) * 65 + wn] * f8scale, a1 = tile[(16 * wk + 4 * j + 1) * 65 + wn] * f8scale, a2 = tile[(16 * wk + 4 * j + 2) * 65 + wn] * f8scale, a3 = tile[(16 * wk + 4 * j + 3) * 65 + wn] * f8scale;
                        w[j] = pg8::pk_fp8x4(a0, a1, a2, a3); }
                    *(uint4*)((unsigned char*)dst + (size_t)r * dst_ld + dst_koff + k0 + 16 * wk) = make_uint4(w[0], w[1], w[2], w[3]); }
                else { unsigned w[8]; float kg[16];
#pragma unroll
                    for (int j = 0; j < 16; ++j) kg[j] = kgain ? kgain[k0 + 16 * wk + j] : 1.0f;
#pragma unroll
                    for (int j = 0; j < 8; ++j) w[j] = (unsigned)f2bf(tile[(16 * wk + 2 * j) * 65 + wn] * kg[2 * j]) | ((unsigned)f2bf(tile[(16 * wk + 2 * j + 1) * 65 + wn] * kg[2 * j + 1]) << 16);
                    uint4* dp = (uint4*)(dst + (size_t)r * dst_ld + dst_koff + k0 + 16 * wk);
                    dp[0] = make_uint4(w[0], w[1], w[2], w[3]); dp[1] = make_uint4(w[4], w[5], w[6], w[7]); } } }
        asm volatile("s_waitcnt lgkmcnt(0)" ::: "memory"); __builtin_amdgcn_s_barrier(); asm volatile("" ::: "memory");
    }
}

template <bool ROUTE> __device__ __forceinline__ void norm_rows(const float* __restrict__ x, const float* __restrict__ g, bf16* __restrict__ h, const float* __restrict__ wr, float* __restrict__ gates, int G, int bid) {
    const int tid_ = otid(); const int lane = tid_ & 63, gw = bid * NWAVE + (tid_ >> 6), nw = G * NWAVE;
    for (int row = gw; row < T_; row += nw) {
        const f32x4* xr = (const f32x4*)(x + (size_t)row * D_);
        f32x4 v[4]; float ss = 0.f;
#pragma unroll
        for (int j = 0; j < 4; ++j) { v[j] = xr[lane + 64 * j]; ss += v[j][0] * v[j][0] + v[j][1] * v[j][1] + v[j][2] * v[j][2] + v[j][3] * v[j][3]; }
        ss = wave_sum(ss);
        const float rs = 1.0f / sqrtf(ss * (1.0f / D_) + EPS_);
#pragma unroll
        for (int j = 0; j < 4; ++j) { const f32x4 gv = ((const f32x4*)g)[lane + 64 * j];
            v[j] = v[j] * gv * rs;
            uint2 o; o.x = (unsigned)f2bf(v[j][0]) | ((unsigned)f2bf(v[j][1]) << 16); o.y = (unsigned)f2bf(v[j][2]) | ((unsigned)f2bf(v[j][3]) << 16);
            *(uint2*)(h + (size_t)row * D_ + (lane + 64 * j) * 4) = o; }
        if (ROUTE) {
            float lg[8];
#pragma unroll
            for (int e = 0; e < 8; ++e) lg[e] = 0.f;
#pragma unroll
            for (int j = 0; j < 4; ++j) {
#pragma unroll
                for (int i = 0; i < 4; ++i) { const f32x4* w = (const f32x4*)(wr + (size_t)((lane + 64 * j) * 4 + i) * 8); const f32x4 w0 = w[0], w1 = w[1]; const float xv = v[j][i];
                    lg[0] += xv * w0[0]; lg[1] += xv * w0[1]; lg[2] += xv * w0[2]; lg[3] += xv * w0[3];
                    lg[4] += xv * w1[0]; lg[5] += xv * w1[1]; lg[6] += xv * w1[2]; lg[7] += xv * w1[3]; } }
#pragma unroll
            for (int e = 0; e < 8; ++e) lg[e] = wave_sum(lg[e]);
            int i1 = 0; float v1 = lg[0];
#pragma unroll
            for (int e = 1; e < 8; ++e) if (lg[e] > v1) { v1 = lg[e]; i1 = e; }
            int i2 = -1; float v2 = -3.0e38f;
#pragma unroll
            for (int e = 0; e < 8; ++e) if (e != i1 && lg[e] > v2) { v2 = lg[e]; i2 = e; }
            const float w1 = 1.0f / (1.0f + __expf(v2 - v1)), w2 = 1.0f - w1;
            if (lane < 8) gates[(size_t)row * 8 + lane] = (lane == i1) ? w1 : ((lane == i2) ? w2 : 0.f);
        }
    }
}

__device__ __forceinline__ void norm_route_rows(LAS unsigned char* lds, const bf16* __restrict__ x, const float* __restrict__ g, bf16* __restrict__ h, const float* __restrict__ wr, int* __restrict__ cnt,
                                                int* __restrict__ idx, float* __restrict__ wrow, int cap, int G, int bid) {
    LAS int* lcnt = (LAS int*)lds; LAS int* gbase = lcnt + 16; LAS int* rl = gbase + 16; LAS int* rp = rl + 256; LAS int* rt = rp + 256; LAS float* rw = (LAS float*)(rt + 128);
    const int tid = otid(), lane = tid & 63, wv = tid >> 6, gw = bid * NWAVE + wv, nw = G * NWAVE;
    if (tid < 16) lcnt[tid] = 0;
    if (tid < 128) rt[tid] = -1;
    __syncthreads();
    int it = 0;
    pg8::u32x4 pn[2];
#pragma unroll
    for (int j = 0; j < 2; ++j) pn[j] = (gw < T_) ? ((const pg8::u32x4*)(x + (size_t)gw * D_))[lane + 64 * j] : (pg8::u32x4){0u, 0u, 0u, 0u};
    for (int row = gw; row < T_; row += nw, ++it) {
        f32x4 v[4]; float ss = 0.f;
#pragma unroll
        for (int j = 0; j < 2; ++j) pg8::unpack8(pn[j], v[2 * j], v[2 * j + 1]);
        if (row + nw < T_) {
#pragma unroll
            for (int j = 0; j < 2; ++j) pn[j] = ((const pg8::u32x4*)(x + (size_t)(row + nw) * D_))[lane + 64 * j]; }
#pragma unroll
        for (int j = 0; j < 4; ++j) ss += v[j][0] * v[j][0] + v[j][1] * v[j][1] + v[j][2] * v[j][2] + v[j][3] * v[j][3];
        ss = wave_sum(ss);
        const float rs = 1.0f / sqrtf(ss * (1.0f / D_) + EPS_);
#pragma unroll
        for (int j = 0; j < 4; ++j) { const int e0 = (lane + 64 * (j >> 1)) * 8 + 4 * (j & 1); const f32x4 gv = *(const f32x4*)(g + e0);
            v[j] = v[j] * gv * rs;
            *(unsigned*)((unsigned char*)h + (size_t)row * D_ + e0) = pg8::pk_fp8x4(v[j][0] * 16.0f, v[j][1] * 16.0f, v[j][2] * 16.0f, v[j][3] * 16.0f); }
        f32x4 lga = {0.f, 0.f, 0.f, 0.f}, lgb = {0.f, 0.f, 0.f, 0.f};
#pragma unroll
        for (int j = 0; j < 4; ++j) {
#pragma unroll
            for (int i = 0; i < 4; ++i) { const f32x4* w = (const f32x4*)(wr + (size_t)((lane + 64 * (j >> 1)) * 8 + 4 * (j & 1) + i) * 8); const f32x4 w0 = w[0], w1 = w[1]; const float xv = v[j][i];
                lga = w0 * xv + lga; lgb = w1 * xv + lgb; } }
        float lg[8] = {lga[0], lga[1], lga[2], lga[3], lgb[0], lgb[1], lgb[2], lgb[3]};
#pragma unroll
        for (int e = 0; e < 8; ++e) lg[e] = wave_sum(lg[e]);
        int i1 = 0; float v1 = lg[0];
#pragma unroll
        for (int e = 1; e < 8; ++e) if (lg[e] > v1) { v1 = lg[e]; i1 = e; }
        int i2 = -1; float v2 = -3.0e38f;
#pragma unroll
        for (int e = 0; e < 8; ++e) if (e != i1 && lg[e] > v2) { v2 = lg[e]; i2 = e; }
        const float w1 = 1.0f / (1.0f + __expf(v2 - v1)), w2 = 1.0f - w1;
        if (lane == 0 && it < 16) { const int s = wv * 16 + it; const int l1 = i1, l2 = 8 + i2;
            const int p1 = __hip_atomic_fetch_add(lcnt + l1, 1, __ATOMIC_RELAXED, __HIP_MEMORY_SCOPE_WORKGROUP), p2 = __hip_atomic_fetch_add(lcnt + l2, 1, __ATOMIC_RELAXED, __HIP_MEMORY_SCOPE_WORKGROUP);
            rl[s] = l1; rl[128 + s] = l2; rp[s] = p1; rp[128 + s] = p2; rt[s] = row; rw[s] = w1; rw[128 + s] = w2; }
    }
    __syncthreads();
    if (tid < 16) gbase[tid] = __hip_atomic_fetch_add(cnt + tid, lcnt[tid], __ATOMIC_RELAXED, __HIP_MEMORY_SCOPE_AGENT);
    __syncthreads();
    if (tid < 256) { const int k = tid >> 7, s = tid & 127; const int tok = rt[s];
        if (tok >= 0) { const int l = rl[k * 128 + s]; const size_t o = (size_t)l * cap + gbase[l] + rp[k * 128 + s]; idx[o] = tok; wrow[o] = rw[k * 128 + s]; } }
    __syncthreads();
}
__device__ __forceinline__ void cast_rows(const float* __restrict__ x, bf16* __restrict__ sb, float* __restrict__ rs0, int G, int bid) {
    const int tid_ = otid(); const int lane = tid_ & 63, gw = bid * NWAVE + (tid_ >> 6), nw = G * NWAVE;
    for (int row = gw; row < T_; row += 2 * nw) {
        f32x4 v[2][4];
#pragma unroll
        for (int i = 0; i < 2; ++i) { const int r = row + i * nw; if (r < T_) {
#pragma unroll
            for (int j = 0; j < 4; ++j) v[i][j] = *(const f32x4*)(x + (size_t)r * D_ + (lane + 64 * (j >> 1)) * 8 + 4 * (j & 1)); } }
#pragma unroll
        for (int i = 0; i < 2; ++i) { const int r = row + i * nw; if (r < T_) { float ss = 0.f;
#pragma unroll
            for (int j = 0; j < 4; ++j) ss += v[i][j][0] * v[i][j][0] + v[i][j][1] * v[i][j][1] + v[i][j][2] * v[i][j][2] + v[i][j][3] * v[i][j][3];
            ss = wave_sum(ss);
#pragma unroll
            for (int j = 0; j < 2; ++j) ((pg8::u32x4*)(sb + (size_t)r * D_))[lane + 64 * j] = pg8::pack8(v[i][2 * j], v[i][2 * j + 1]);
            if (lane == 0) rs0[r] = 1.0f / sqrtf(ss * (1.0f / D_) + EPS_); } }
    }
}
__device__ __forceinline__ void final_norm_rows(const bf16* __restrict__ x, float* __restrict__ o, const float* __restrict__ g, int G, int bid) {
    const int tid_ = otid(); const int lane = tid_ & 63, gw = bid * NWAVE + (tid_ >> 6), nw = G * NWAVE;
    f32x4 gv[4];
#pragma unroll
    for (int j = 0; j < 4; ++j) gv[j] = *(const f32x4*)(g + (lane + 64 * (j >> 1)) * 8 + 4 * (j & 1));
    for (int row = gw; row < T_; row += 4 * nw) {
        pg8::u32x4 p[4][2];
#pragma unroll
        for (int i = 0; i < 4; ++i) { const int r = row + i * nw; if (r < T_) {
#pragma unroll
            for (int j = 0; j < 2; ++j) p[i][j] = ((const pg8::u32x4*)(x + (size_t)r * D_))[lane + 64 * j]; } }
#pragma unroll
        for (int i = 0; i < 4; ++i) { const int r = row + i * nw; if (r < T_) {
            f32x4 v[4]; float ss = 0.f;
#pragma unroll
            for (int j = 0; j < 2; ++j) pg8::unpack8(p[i][j], v[2 * j], v[2 * j + 1]);
#pragma unroll
            for (int j = 0; j < 4; ++j) ss += v[j][0] * v[j][0] + v[j][1] * v[j][1] + v[j][2] * v[j][2] + v[j][3] * v[j][3];
            ss = wave_sum(ss);
            const float rs = 1.0f / sqrtf(ss * (1.0f / D_) + EPS_);
#pragma unroll
            for (int j = 0; j < 4; ++j) *(f32x4*)(o + (size_t)r * D_ + (lane + 64 * (j >> 1)) * 8 + 4 * (j & 1)) = v[j] * gv[j] * rs; } }
    }
}
__device__ __forceinline__ void norm_rows_b(const bf16* __restrict__ x, const float* __restrict__ g, bf16* __restrict__ h, int G, int bid) {
    const int tid_ = otid(); const int lane = tid_ & 63, gw = bid * NWAVE + (tid_ >> 6), nw = G * NWAVE;
    f32x4 gv[4];
#pragma unroll
    for (int j = 0; j < 4; ++j) gv[j] = *(const f32x4*)(g + (lane + 64 * (j >> 1)) * 8 + 4 * (j & 1));
    for (int row = gw; row < T_; row += 4 * nw) {
        pg8::u32x4 p[4][2];
#pragma unroll
        for (int i = 0; i < 4; ++i) { const int r = row + i * nw; if (r < T_) {
#pragma unroll
            for (int j = 0; j < 2; ++j) p[i][j] = ((const pg8::u32x4*)(x + (size_t)r * D_))[lane + 64 * j]; } }
#pragma unroll
        for (int i = 0; i < 4; ++i) { const int r = row + i * nw; if (r < T_) {
            f32x4 v[4]; float ss = 0.f;
#pragma unroll
            for (int j = 0; j < 2; ++j) pg8::unpack8(p[i][j], v[2 * j], v[2 * j + 1]);
#pragma unroll
            for (int j = 0; j < 4; ++j) ss += v[j][0] * v[j][0] + v[j][1] * v[j][1] + v[j][2] * v[j][2] + v[j][3] * v[j][3];
            ss = wave_sum(ss);
            const float rs = 1.0f / sqrtf(ss * (1.0f / D_) + EPS_);
#pragma unroll
            for (int j = 0; j < 2; ++j) ((pg8::u32x4*)(h + (size_t)r * D_))[lane + 64 * j] = pg8::pack8(v[2 * j] * gv[2 * j] * rs, v[2 * j + 1] * gv[2 * j + 1] * rs); } }
    }
}

__device__ __forceinline__ void rope_table_part(float2* __restrict__ tab, int G, int bid) {
    for (int i = bid * NTHR + otid(); i < S_ * 32; i += G * NTHR) { const int pos = i >> 5, d = i & 31; const float freq = (float)pow(10000.0, -(double)d / 32.0); const float ang = (float)pos * freq;
        tab[i] = make_float2((float)cos((double)ang), (float)sin((double)ang)); }
}
__device__ __forceinline__ void pebias_part(LAS float* red, const float* __restrict__ pe, const float* __restrict__ w1, float* __restrict__ bias1, int G, int bid) {
    const int tid_ = otid();
    for (int o = bid; o < 512; o += G) { const int j = o >> 8, n = o & 255; float s = 0.f;
#pragma unroll
        for (int i = tid_; i < 2048; i += NTHR) s += pe[j * 2048 + i] * w1[((size_t)j * 2048 + i) * 256 + n];
        s = wave_sum(s);
        if ((tid_ & 63) == 0) red[tid_ >> 6] = s;
        __syncthreads();
        if (tid_ == 0) bias1[o] = ((red[0] + red[1]) + (red[2] + red[3])) + ((red[4] + red[5]) + (red[6] + red[7]));
        __syncthreads(); }
}

namespace lru {
#define LRU_LAS __attribute__((address_space(3)))
typedef short bf16x8 __attribute__((ext_vector_type(8)));
typedef float f32x4 __attribute__((ext_vector_type(4)));
typedef float f32x2 __attribute__((ext_vector_type(2)));
constexpr int CHT = 256, APITCH = 208  , A_BYTES = CHT * APITCH, WS_OFF = A_BYTES, DUMP_OFF = A_BYTES + 2 * 2048  , LDS_BYTES = DUMP_OFF + 8192;
#define LRU_GAS __attribute__((address_space(1)))
__device__ __forceinline__ LRU_GAS char* sptr(const char* p) { unsigned long v = (unsigned long)p; asm("" : "+s"(v)); return (LRU_GAS char*)v; }
__device__ __forceinline__ unsigned cvtpk(float lo, float hi) { unsigned r; asm("v_cvt_pk_bf16_f32 %0, %1, %2" : "=v"(r) : "v"(lo), "v"(hi)); return r; }
__device__ __forceinline__ void lru_unit(LRU_LAS unsigned char* lds, int u, const bf16* __restrict__ proj, const float* __restrict__ conv_w, const float* __restrict__ conv_b, const float* __restrict__ w_a,
                                         const float* __restrict__ b_a, const float* __restrict__ w_i, const float* __restrict__ b_i, const float* __restrict__ lam, bf16* __restrict__ y) {
    int tid_raw = threadIdx.x; asm volatile("" : "+v"(tid_raw));
    const int tid = tid_raw, lane = tid & 63, w = __builtin_amdgcn_readfirstlane(tid >> 6), col = lane & 15, fq = lane >> 4;
    const int b = u >> 6, n = (u >> 2) & 15, q = u & 3;
    constexpr float L2E = 1.4426950408889634f;
    bf16x8 Ba[2][3], Bi[2][3];
#pragma unroll
    for (int nt = 0; nt < 2; ++nt)
#pragma unroll
        for (int ks = 0; ks < 3; ++ks)
#pragma unroll
            for (int i = 0; i < 8; ++i) { const int k = 32 * ks + 8 * fq + i, d = 16 * nt + col; const bool ok = (k < BW_) && (d < 22);
                const size_t off = (size_t)(n * BW_ + (ok ? k : 0)) * BW_ + 22 * q + (ok ? d : 0);
                const float mk = ok ? -L2E : 0.f;
                Ba[nt][ks][i] = (short)f2bf(mk * w_a[off]); Bi[nt][ks][i] = (short)f2bf(mk * w_i[off]); }
    float ba[2], bi[2], c2[2]; bool vch[2]; int dch[2];
#pragma unroll
    for (int nt = 0; nt < 2; ++nt) { const int d = 16 * nt + col; vch[nt] = d < 22; dch[nt] = vch[nt] ? d : 0; const int ch = n * BW_ + 22 * q + dch[nt];
        ba[nt] = -L2E * b_a[ch]; bi[nt] = -L2E * b_i[ch]; c2[nt] = -8.0f * L2E * log1pf(expf(-lam[ch])); }
    const bool cact = lane < 44; const int cch = n * BW_ + 2 * (cact ? lane : 0);
    f32x2 cw[4], cb;
#pragma unroll
    for (int k = 0; k < 4; ++k) { cw[k].x = cact ? conv_w[k * DR_ + cch] : 0.f; cw[k].y = cact ? conv_w[k * DR_ + cch + 1] : 0.f; }
    cb.x = cact ? conv_b[cch] : 0.f; cb.y = cact ? conv_b[cch + 1] : 0.f;
    float hc[2] = {0.f, 0.f};
    const char* uxr = (const char*)proj + ((size_t)b * S_ * (2 * DR_) + DR_ + n * BW_) * 2;   const unsigned vxr = cact ? 4u * lane : 0u;
    const char* ugt = (const char*)proj + ((size_t)b * S_ * (2 * DR_) + n * BW_ + 22 * q) * 2;
    char* uy = (char*)y + ((size_t)b * S_ * DR_ + n * BW_ + 22 * q) * 2;
    unsigned vgt[2], vy[2];
#pragma unroll
    for (int nt = 0; nt < 2; ++nt) { vgt[nt] = (unsigned)(4 * fq * (2 * DR_) + dch[nt]) * 2u; vy[nt] = (unsigned)(4 * fq * DR_ + dch[nt]) * 2u; }
    LRU_LAS unsigned char* At = lds;
    LRU_LAS unsigned char* cwr = (lane < 48) ? At + 32 * w * APITCH + 4 * lane : lds + DUMP_OFF + 4 * lane;
    unsigned xr[35];
#pragma unroll
    for (int r = 0; r < 35; ++r) { const int t = 32 * w - 3 + r; xr[r] = (t >= 0) ? *(const unsigned*)(uxr + (size_t)(t >= 0 ? t : 0) * (2 * DR_ * 2) + vxr) : 0u; }
    for (int c = 0; c < S_ / CHT; ++c) {
        const int t0 = c * CHT;
        bf16 gt[2][2][4]; unsigned vg0 = vgt[0], vg1 = vgt[1]; asm volatile("" : "+v"(vg0), "+v"(vg1));
#pragma unroll
        for (int mt = 0; mt < 2; ++mt)
#pragma unroll
            for (int j = 0; j < 4; ++j) { const LRU_GAS char* rowp = sptr(ugt + (size_t)(t0 + 32 * w + 16 * mt + j) * (2 * DR_ * 2));
#pragma unroll
                for (int nt = 0; nt < 2; ++nt) gt[mt][nt][j] = *(const LRU_GAS bf16*)(rowp + (nt ? vg1 : vg0)); }
        {
            f32x2 xu[35];
#pragma unroll
            for (int r = 0; r < 35; ++r) { xu[r].x = __uint_as_float(xr[r] << 16); xu[r].y = __uint_as_float(xr[r] & 0xffff0000u); }
#pragma unroll
            for (int r = 0; r < 32; ++r) {
                f32x2 x = cb;
#pragma unroll
                for (int k = 0; k < 4; ++k) x = __builtin_elementwise_fma(cw[k], xu[r + k], x);
                *(LRU_LAS unsigned*)(cwr + r * APITCH) = cvtpk(x.x, x.y);
            }
        }
        if (c + 1 < S_ / CHT) {
            const char* rowp = uxr + (size_t)(t0 + CHT + 32 * w - 3) * (2 * DR_ * 2); unsigned vx = vxr; asm volatile("" : "+v"(vx));
#pragma unroll
            for (int r = 0; r < 35; ++r) xr[r] = *(const LRU_GAS unsigned*)(sptr(rowp + (size_t)r * (2 * DR_ * 2)) + vx);
        }
        asm volatile("s_waitcnt lgkmcnt(0)" ::: "memory");
        f32x4 aa[2][2], ai[2][2];
#pragma unroll
        for (int mt = 0; mt < 2; ++mt)
#pragma unroll
            for (int nt = 0; nt < 2; ++nt) { aa[mt][nt] = (f32x4){ba[nt], ba[nt], ba[nt], ba[nt]}; ai[mt][nt] = (f32x4){bi[nt], bi[nt], bi[nt], bi[nt]}; }
#pragma unroll
        for (int mt = 0; mt < 2; ++mt)
#pragma unroll
            for (int ks = 0; ks < 3; ++ks) { const bf16x8 af = *(const LRU_LAS bf16x8*)(At + (32 * w + 16 * mt + col) * APITCH + (32 * ks + 8 * fq) * 2);
#pragma unroll
                for (int nt = 0; nt < 2; ++nt) { aa[mt][nt] = __builtin_amdgcn_mfma_f32_16x16x32_bf16(af, Ba[nt][ks], aa[mt][nt], 0, 0, 0);
                                                 ai[mt][nt] = __builtin_amdgcn_mfma_f32_16x16x32_bf16(af, Bi[nt][ks], ai[mt][nt], 0, 0, 0); } }
        const bool first = (c == 0) && (w == 0) && (fq == 0);
        float hl[2][2][4], ca[2][2][4];
#pragma unroll
        for (int mt = 0; mt < 2; ++mt)
#pragma unroll
            for (int nt = 0; nt < 2; ++nt) { float hprev = 0.f, aprev = 1.f;
                f32x4 e1 = aa[mt][nt], e2 = ai[mt][nt], xc4;
#pragma unroll
                for (int j = 0; j < 4; ++j) { e1[j] = __builtin_amdgcn_exp2f(e1[j]); e2[j] = __builtin_amdgcn_exp2f(e2[j]);
                    xc4[j] = bf2f(*(const LRU_LAS bf16*)(At + (32 * w + 16 * mt + 4 * fq + j) * APITCH + (22 * q + dch[nt]) * 2)); }
                f32x4 r4 = e1 + 1.0f, ig4 = e2 + 1.0f;
#pragma unroll
                for (int j = 0; j < 4; ++j) { r4[j] = __builtin_amdgcn_rcpf(r4[j]); ig4[j] = __builtin_amdgcn_rcpf(ig4[j]); }
                f32x4 a4 = r4 * c2[nt];
#pragma unroll
                for (int j = 0; j < 4; ++j) a4[j] = __builtin_amdgcn_exp2f(a4[j]);
                f32x4 m4 = 1.0f - a4 * a4;
#pragma unroll
                for (int j = 0; j < 4; ++j) m4[j] = __builtin_amdgcn_sqrtf(fmaxf(m4[j], 0.f));
                if (mt == 0) m4[0] = first ? 1.0f : m4[0];
                const f32x4 uu4 = m4 * (ig4 * xc4);
#pragma unroll
                for (int j = 0; j < 4; ++j) { hprev = a4[j] * hprev + uu4[j]; aprev = a4[j] * aprev; hl[mt][nt][j] = hprev; ca[mt][nt][j] = aprev; } }
        float exA[2][2], exH[2][2], wA[2], wH[2];
#pragma unroll
        for (int nt = 0; nt < 2; ++nt) { float tA[2], tH[2];
#pragma unroll
            for (int mt = 0; mt < 2; ++mt) { float A = ca[mt][nt][3], H = hl[mt][nt][3];
                float Ap = __shfl_up(A, 16), Hp = __shfl_up(H, 16); if (fq >= 1) { H = A * Hp + H; A = A * Ap; }
                Ap = __shfl_up(A, 32); Hp = __shfl_up(H, 32); if (fq >= 2) { H = A * Hp + H; A = A * Ap; }
                const float eA = __shfl_up(A, 16), eH = __shfl_up(H, 16); exA[mt][nt] = fq ? eA : 1.0f; exH[mt][nt] = fq ? eH : 0.f;
                tA[mt] = __shfl(A, col + 48); tH[mt] = __shfl(H, col + 48); }
            exH[1][nt] = exA[1][nt] * tH[0] + exH[1][nt]; exA[1][nt] = exA[1][nt] * tA[0];
            wA[nt] = tA[1] * tA[0]; wH[nt] = tA[1] * tH[0] + tH[1]; }
        LRU_LAS f32x2* ws = (LRU_LAS f32x2*)(lds + WS_OFF + (c & 1) * 2048);
        if (fq == 0) { ws[w * 32 + col] = (f32x2){wA[0], wH[0]}; ws[w * 32 + 16 + col] = (f32x2){wA[1], wH[1]}; }
        asm volatile("s_waitcnt lgkmcnt(0)" ::: "memory");
        __builtin_amdgcn_s_barrier();
        asm volatile("" ::: "memory");
        unsigned o[2][2][2];
#pragma unroll
        for (int nt = 0; nt < 2; ++nt) { float cin = hc[nt], cend = hc[nt];
#pragma unroll
            for (int ww = 0; ww < 8; ++ww) { const f32x2 s = ws[ww * 32 + 16 * nt + col]; cend = s.x * cend + s.y; if (ww < w) cin = cend; }
            hc[nt] = cend;
#pragma unroll
            for (int mt = 0; mt < 2; ++mt) { const float sc = exA[mt][nt] * cin + exH[mt][nt];
#pragma unroll
                for (int j2 = 0; j2 < 2; ++j2) o[nt][mt][j2] = cvtpk((hl[mt][nt][2 * j2] + ca[mt][nt][2 * j2] * sc) * bf2f(gt[mt][nt][2 * j2]), (hl[mt][nt][2 * j2 + 1] + ca[mt][nt][2 * j2 + 1] * sc) * bf2f(gt[mt][nt][2 * j2 + 1])); } }
#pragma unroll
        for (int nt = 0; nt < 2; ++nt)
            if (vch[nt]) { unsigned vyo = vy[nt]; asm volatile("" : "+v"(vyo));
#pragma unroll
                for (int mt = 0; mt < 2; ++mt)
#pragma unroll
                    for (int j2 = 0; j2 < 2; ++j2) { LRU_GAS char* rowp = sptr(uy + (size_t)(t0 + 32 * w + 16 * mt + 2 * j2) * (DR_ * 2));
                        *(LRU_GAS bf16*)(rowp + vyo) = (bf16)(o[nt][mt][j2] & 0xffffu); *(LRU_GAS bf16*)(rowp + DR_ * 2 + vyo) = (bf16)(o[nt][mt][j2] >> 16); } }
    }
}
}

namespace nsa {
typedef short bf16x8 __attribute__((ext_vector_type(8)));
typedef short s16x4 __attribute__((ext_vector_type(4)));
typedef unsigned u32x4 __attribute__((ext_vector_type(4)));
typedef float f32x8 __attribute__((ext_vector_type(8)));
typedef __bf16 bf16x8n __attribute__((ext_vector_type(8)));
constexpr int TILE_B = 64 * 128, BUF_B = 2 * TILE_B, NBUF = 4;
constexpr int OFF_G = NBUF * BUF_B, OFF_E3 = OFF_G + 32768;
constexpr int OFF_ACC = OFF_G, OFF_ML = OFF_ACC + 65536, OFF_AM = OFF_ML + 2048, OFF_QL = OFF_AM + 1024, OFF_QC = OFF_QL + 4096, OFF_TL = OFF_QC + 256, OFF_SEL = OFF_TL + 128, OFF_UNI = OFF_SEL + 1024, OFF_REC = OFF_UNI + 64  , OFF_END = OFF_REC + 2048;
static_assert(OFF_E3 + 32768 <= OFF_ML && OFF_END <= 159744, "attention LDS map");
constexpr int SEL_DENSE_QB = 28;
__device__ __forceinline__ int swz(int row, int chunk) { return row * 128 + ((chunk ^ ((row >> 1) & 7)) << 4); }
#define NSA_NEG (-INFINITY)

__device__ __forceinline__ unsigned pk_bf16(float lo, float hi) { unsigned r; asm volatile("v_cvt_pk_bf16_f32 %0, %1, %2" : "=v"(r) : "v"(lo), "v"(hi)); return r; }

__device__ __forceinline__ float xmax16(float x) { const auto r = __builtin_amdgcn_permlane16_swap(__float_as_uint(x), __float_as_uint(x), false, false); return fmaxf(__uint_as_float(r[0]), __uint_as_float(r[1])); }
__device__ __forceinline__ float xmax32(float x) { const auto r = __builtin_amdgcn_permlane32_swap(__float_as_uint(x), __float_as_uint(x), false, false); return fmaxf(__uint_as_float(r[0]), __uint_as_float(r[1])); }
__device__ __forceinline__ float xsum16(float x) { const auto r = __builtin_amdgcn_permlane16_swap(__float_as_uint(x), __float_as_uint(x), false, false); return __uint_as_float(r[0]) + __uint_as_float(r[1]); }
__device__ __forceinline__ float xsum32(float x) { const auto r = __builtin_amdgcn_permlane32_swap(__float_as_uint(x), __float_as_uint(x), false, false); return __uint_as_float(r[0]) + __uint_as_float(r[1]); }
__device__ __forceinline__ float qx1(float x) { return __uint_as_float((unsigned)__builtin_amdgcn_update_dpp(0, (int)__float_as_uint(x), 0xB1, 0xF, 0xF, false)); }
__device__ __forceinline__ float qx2(float x) { return __uint_as_float((unsigned)__builtin_amdgcn_update_dpp(0, (int)__float_as_uint(x), 0x4E, 0xF, 0xF, false)); }
constexpr float LOG2E = 1.4426950408889634f;
template <int MODE, bool MASKED>
__device__ __forceinline__ void visit(const LAS unsigned char* Kt, const LAS unsigned char* Vt, const bool (&act)[2], const bool (&on)[2], const bf16x8 (&Qf)[2][2], const int (&klo)[2], const int (&khi)[2],
                                      float (&m)[2], float (&l)[2], f32x4 (&O)[2][4], const float (&invl)[2], LAS float* Gs, LAS float* E3s, int nbase, int col, int fq) {
    f32x4 S[2][4];
    const f32x4 zero4 = {0.f, 0.f, 0.f, 0.f};
#pragma unroll
    for (int kt = 0; kt < 4; ++kt) { const bf16x8 kf0 = *(const LAS bf16x8*)(Kt + swz(16 * kt + col, fq)), kf1 = *(const LAS bf16x8*)(Kt + swz(16 * kt + col, 4 + fq));
        if (act[0]) { S[0][kt] = __builtin_amdgcn_mfma_f32_16x16x32_bf16(kf0, Qf[0][0], zero4, 0, 0, 0); S[0][kt] = __builtin_amdgcn_mfma_f32_16x16x32_bf16(kf1, Qf[0][1], S[0][kt], 0, 0, 0); }
        if (act[1]) { S[1][kt] = __builtin_amdgcn_mfma_f32_16x16x32_bf16(kf0, Qf[1][0], zero4, 0, 0, 0); S[1][kt] = __builtin_amdgcn_mfma_f32_16x16x32_bf16(kf1, Qf[1][1], S[1][kt], 0, 0, 0); } }
    bf16x8 P[2][2];
#pragma unroll
    for (int cg = 0; cg < 2; ++cg) {
        if (act[cg]) {
            if (MASKED) {
#pragma unroll
                for (int kt = 0; kt < 4; ++kt)
#pragma unroll
                    for (int j = 0; j < 4; ++j) { const int key = 16 * kt + 4 * fq + j; if (key < klo[cg] || key > khi[cg]) S[cg][kt][j] = NSA_NEG; }
            }
            float nb;
            if (MODE == 2) { nb = (m[cg] == NSA_NEG) ? 0.f : -m[cg] * LOG2E; }
            else {
                float mx = fmaxf(fmaxf(S[cg][0][0], S[cg][0][1]), S[cg][0][2]);
                mx = fmaxf(fmaxf(mx, S[cg][0][3]), S[cg][1][0]); mx = fmaxf(fmaxf(mx, S[cg][1][1]), S[cg][1][2]); mx = fmaxf(fmaxf(mx, S[cg][1][3]), S[cg][2][0]);
                mx = fmaxf(fmaxf(mx, S[cg][2][1]), S[cg][2][2]); mx = fmaxf(fmaxf(mx, S[cg][2][3]), S[cg][3][0]); mx = fmaxf(fmaxf(mx, S[cg][3][1]), S[cg][3][2]); mx = fmaxf(mx, S[cg][3][3]);
                mx = xmax16(mx); mx = xmax32(mx);
                if (!MASKED) mx = on[cg] ? mx : NSA_NEG;
                const float mnew = fmaxf(m[cg], mx), msafe = (mnew == NSA_NEG) ? 0.f : mnew;
                nb = -msafe * LOG2E;
                if (__ballot(mnew != m[cg]) != 0ull) {
                    const float alpha = __builtin_amdgcn_exp2f((m[cg] - msafe) * LOG2E);
                    m[cg] = mnew; l[cg] *= alpha;
                    if (MODE == 0) {
#pragma unroll
                        for (int dt = 0; dt < 4; ++dt) O[cg][dt] = O[cg][dt] * alpha; } }
            }
            if (!MASKED) nb = on[cg] ? nb : NSA_NEG;
            f32x4 ls4 = (f32x4){0.f, 0.f, 0.f, 0.f};
#pragma unroll
            for (int kt = 0; kt < 4; ++kt) { f32x4 a = S[cg][kt] * LOG2E + nb;
                a[0] = __builtin_amdgcn_exp2f(a[0]); a[1] = __builtin_amdgcn_exp2f(a[1]); a[2] = __builtin_amdgcn_exp2f(a[2]); a[3] = __builtin_amdgcn_exp2f(a[3]);
                if (MODE == 2) a = a * invl[cg];
                S[cg][kt] = a; ls4 = ls4 + a; }
            if (MODE != 2) l[cg] += (ls4[0] + ls4[1]) + (ls4[2] + ls4[3]);
            if (MODE != 1) {
#pragma unroll
                for (int kp = 0; kp < 2; ++kp) { const f32x4 a = S[cg][2 * kp], c = S[cg][2 * kp + 1]; const f32x8 f = {a[0], a[1], a[2], a[3], c[0], c[1], c[2], c[3]};
                    P[cg][kp] = __builtin_bit_cast(bf16x8, __builtin_convertvector(f, bf16x8n)); }
            }
            if (MODE == 2) {
#pragma unroll
                for (int kt = 0; kt < 4; ++kt) { float gs = 2.f * (S[cg][kt][0] + S[cg][kt][1] + S[cg][kt][2]) + S[cg][kt][3], e3 = S[cg][kt][3];
                    gs += qx1(gs); gs += qx2(gs); e3 += qx1(e3); e3 += qx2(e3);
                    if ((col & 3) == 0) { const int o = (4 * cg + (col >> 2)) * 128 + nbase + 4 * kt + fq; Gs[o] = gs; E3s[o] = e3; } }
            }
        }
    }
    if (MODE != 1) {
#pragma unroll
        for (int dt = 0; dt < 4; ++dt)
#pragma unroll
            for (int kp = 0; kp < 2; ++kp) { const int vr0 = 32 * kp + 4 * fq + (col >> 2), vch = 2 * dt + ((col & 3) >> 1), vh = (col & 1) * 8;
                const s16x4 v0 = __builtin_amdgcn_ds_read_tr16_b64_v4i16((LAS s16x4*)(Vt + swz(vr0, vch) + vh)), v1 = __builtin_amdgcn_ds_read_tr16_b64_v4i16((LAS s16x4*)(Vt + swz(vr0 + 16, vch) + vh));
                const bf16x8 vf = {v0[0], v0[1], v0[2], v0[3], v1[0], v1[1], v1[2], v1[3]};
                if (act[0]) O[0][dt] = __builtin_amdgcn_mfma_f32_16x16x32_bf16(vf, P[0][kp], O[0][dt], 0, 0, 0);
                if (act[1]) O[1][dt] = __builtin_amdgcn_mfma_f32_16x16x32_bf16(vf, P[1][kp], O[1][dt], 0, 0, 0); }
    }
}

template <int MODE>
__device__ __forceinline__ void visitw(const LAS unsigned char* Ka, const LAS unsigned char* Va, const LAS unsigned char* Kb, const LAS unsigned char* Vb, const bf16x8 (&Qf)[2][2],
                                       float (&m)[2], float (&l)[2], f32x4 (&O)[2][4], const float (&invl)[2], LAS float* Gs, LAS float* E3s, int nbase_a, int nbase_b, int col, int fq) {
    f32x4 Sa[2][4], Sb[2][4];
    const f32x4 zero4 = {0.f, 0.f, 0.f, 0.f};
#pragma unroll
    for (int kt = 0; kt < 4; ++kt) { const bf16x8 kf0 = *(const LAS bf16x8*)(Ka + swz(16 * kt + col, fq)), kf1 = *(const LAS bf16x8*)(Ka + swz(16 * kt + col, 4 + fq));
        Sa[0][kt] = __builtin_amdgcn_mfma_f32_16x16x32_bf16(kf0, Qf[0][0], zero4, 0, 0, 0); Sa[0][kt] = __builtin_amdgcn_mfma_f32_16x16x32_bf16(kf1, Qf[0][1], Sa[0][kt], 0, 0, 0);
        Sa[1][kt] = __builtin_amdgcn_mfma_f32_16x16x32_bf16(kf0, Qf[1][0], zero4, 0, 0, 0); Sa[1][kt] = __builtin_amdgcn_mfma_f32_16x16x32_bf16(kf1, Qf[1][1], Sa[1][kt], 0, 0, 0); }
#pragma unroll
    for (int kt = 0; kt < 4; ++kt) { const bf16x8 kf0 = *(const LAS bf16x8*)(Kb + swz(16 * kt + col, fq)), kf1 = *(const LAS bf16x8*)(Kb + swz(16 * kt + col, 4 + fq));
        Sb[0][kt] = __builtin_amdgcn_mfma_f32_16x16x32_bf16(kf0, Qf[0][0], zero4, 0, 0, 0); Sb[0][kt] = __builtin_amdgcn_mfma_f32_16x16x32_bf16(kf1, Qf[0][1], Sb[0][kt], 0, 0, 0);
        Sb[1][kt] = __builtin_amdgcn_mfma_f32_16x16x32_bf16(kf0, Qf[1][0], zero4, 0, 0, 0); Sb[1][kt] = __builtin_amdgcn_mfma_f32_16x16x32_bf16(kf1, Qf[1][1], Sb[1][kt], 0, 0, 0); }
    bf16x8 Pa[2][2], Pb[2][2];
#pragma unroll
    for (int cg = 0; cg < 2; ++cg) {
        float nb;
        if (MODE == 2) { nb = (m[cg] == NSA_NEG) ? 0.f : -m[cg] * LOG2E; }
        else {
            float mx = fmaxf(fmaxf(Sa[cg][0][0], Sa[cg][0][1]), Sa[cg][0][2]);
            mx = fmaxf(fmaxf(mx, Sa[cg][0][3]), Sa[cg][1][0]); mx = fmaxf(fmaxf(mx, Sa[cg][1][1]), Sa[cg][1][2]); mx = fmaxf(fmaxf(mx, Sa[cg][1][3]), Sa[cg][2][0]);
            mx = fmaxf(fmaxf(mx, Sa[cg][2][1]), Sa[cg][2][2]); mx = fmaxf(fmaxf(mx, Sa[cg][2][3]), Sa[cg][3][0]); mx = fmaxf(fmaxf(mx, Sa[cg][3][1]), Sa[cg][3][2]); mx = fmaxf(mx, Sa[cg][3][3]);
            mx = fmaxf(fmaxf(mx, Sb[cg][0][0]), Sb[cg][0][1]); mx = fmaxf(fmaxf(mx, Sb[cg][0][2]), Sb[cg][0][3]); mx = fmaxf(fmaxf(mx, Sb[cg][1][0]), Sb[cg][1][1]); mx = fmaxf(fmaxf(mx, Sb[cg][1][2]), Sb[cg][1][3]);
            mx = fmaxf(fmaxf(mx, Sb[cg][2][0]), Sb[cg][2][1]); mx = fmaxf(fmaxf(mx, Sb[cg][2][2]), Sb[cg][2][3]); mx = fmaxf(fmaxf(mx, Sb[cg][3][0]), Sb[cg][3][1]); mx = fmaxf(fmaxf(mx, Sb[cg][3][2]), Sb[cg][3][3]);
            mx = xmax16(mx); mx = xmax32(mx);
            const float mnew = fmaxf(m[cg], mx), msafe = (mnew == NSA_NEG) ? 0.f : mnew;
            nb = -msafe * LOG2E;
            if (__ballot(mnew != m[cg]) != 0ull) {
                const float alpha = __builtin_amdgcn_exp2f((m[cg] - msafe) * LOG2E);
                m[cg] = mnew; l[cg] *= alpha;
                if (MODE == 0) {
#pragma unroll
                    for (int dt = 0; dt < 4; ++dt) O[cg][dt] = O[cg][dt] * alpha; } }
        }
        f32x4 ls4 = (f32x4){0.f, 0.f, 0.f, 0.f};
#pragma unroll
        for (int kt = 0; kt < 4; ++kt) { f32x4 a = Sa[cg][kt] * LOG2E + nb;
            a[0] = __builtin_amdgcn_exp2f(a[0]); a[1] = __builtin_amdgcn_exp2f(a[1]); a[2] = __builtin_amdgcn_exp2f(a[2]); a[3] = __builtin_amdgcn_exp2f(a[3]);
            if (MODE == 2) a = a * invl[cg];
            Sa[cg][kt] = a; ls4 = ls4 + a; }
#pragma unroll
        for (int kt = 0; kt < 4; ++kt) { f32x4 a = Sb[cg][kt] * LOG2E + nb;
            a[0] = __builtin_amdgcn_exp2f(a[0]); a[1] = __builtin_amdgcn_exp2f(a[1]); a[2] = __builtin_amdgcn_exp2f(a[2]); a[3] = __builtin_amdgcn_exp2f(a[3]);
            if (MODE == 2) a = a * invl[cg];
            Sb[cg][kt] = a; ls4 = ls4 + a; }
        if (MODE != 2) l[cg] += (ls4[0] + ls4[1]) + (ls4[2] + ls4[3]);
        if (MODE != 1) {
#pragma unroll
            for (int kp = 0; kp < 2; ++kp) { const f32x4 a = Sa[cg][2 * kp], c = Sa[cg][2 * kp + 1]; const f32x8 f = {a[0], a[1], a[2], a[3], c[0], c[1], c[2], c[3]};
                Pa[cg][kp] = __builtin_bit_cast(bf16x8, __builtin_convertvector(f, bf16x8n)); }
#pragma unroll
            for (int kp = 0; kp < 2; ++kp) { const f32x4 a = Sb[cg][2 * kp], c = Sb[cg][2 * kp + 1]; const f32x8 f = {a[0], a[1], a[2], a[3], c[0], c[1], c[2], c[3]};
                Pb[cg][kp] = __builtin_bit_cast(bf16x8, __builtin_convertvector(f, bf16x8n)); }
        }
        if (MODE == 2) {
#pragma unroll
            for (int kt = 0; kt < 4; ++kt) { float gs = 2.f * (Sa[cg][kt][0] + Sa[cg][kt][1] + Sa[cg][kt][2]) + Sa[cg][kt][3], e3 = Sa[cg][kt][3];
                gs += qx1(gs); gs += qx2(gs); e3 += qx1(e3); e3 += qx2(e3);
                if ((col & 3) == 0) { const int o = (4 * cg + (col >> 2)) * 128 + nbase_a + 4 * kt + fq; Gs[o] = gs; E3s[o] = e3; } }
#pragma unroll
            for (int kt = 0; kt < 4; ++kt) { float gs = 2.f * (Sb[cg][kt][0] + Sb[cg][kt][1] + Sb[cg][kt][2]) + Sb[cg][kt][3], e3 = Sb[cg][kt][3];
                gs += qx1(gs); gs += qx2(gs); e3 += qx1(e3); e3 += qx2(e3);
                if ((col & 3) == 0) { const int o = (4 * cg + (col >> 2)) * 128 + nbase_b + 4 * kt + fq; Gs[o] = gs; E3s[o] = e3; } }
        }
    }
    if (MODE != 1) {
#pragma unroll
        for (int dt = 0; dt < 4; ++dt)
#pragma unroll
            for (int kp = 0; kp < 2; ++kp) { const int vr0 = 32 * kp + 4 * fq + (col >> 2), vch = 2 * dt + ((col & 3) >> 1), vh = (col & 1) * 8;
                const s16x4 v0 = __builtin_amdgcn_ds_read_tr16_b64_v4i16((LAS s16x4*)(Va + swz(vr0, vch) + vh)), v1 = __builtin_amdgcn_ds_read_tr16_b64_v4i16((LAS s16x4*)(Va + swz(vr0 + 16, vch) + vh));
                const bf16x8 vf = {v0[0], v0[1], v0[2], v0[3], v1[0], v1[1], v1[2], v1[3]};
                O[0][dt] = __builtin_amdgcn_mfma_f32_16x16x32_bf16(vf, Pa[0][kp], O[0][dt], 0, 0, 0);
                O[1][dt] = __builtin_amdgcn_mfma_f32_16x16x32_bf16(vf, Pa[1][kp], O[1][dt], 0, 0, 0); }
#pragma unroll
        for (int dt = 0; dt < 4; ++dt)
#pragma unroll
            for (int kp = 0; kp < 2; ++kp) { const int vr0 = 32 * kp + 4 * fq + (col >> 2), vch = 2 * dt + ((col & 3) >> 1), vh = (col & 1) * 8;
                const s16x4 v0 = __builtin_amdgcn_ds_read_tr16_b64_v4i16((LAS s16x4*)(Vb + swz(vr0, vch) + vh)), v1 = __builtin_amdgcn_ds_read_tr16_b64_v4i16((LAS s16x4*)(Vb + swz(vr0 + 16, vch) + vh));
                const bf16x8 vf = {v0[0], v0[1], v0[2], v0[3], v1[0], v1[1], v1[2], v1[3]};
                O[0][dt] = __builtin_amdgcn_mfma_f32_16x16x32_bf16(vf, Pb[0][kp], O[0][dt], 0, 0, 0);
                O[1][dt] = __builtin_amdgcn_mfma_f32_16x16x32_bf16(vf, Pb[1][kp], O[1][dt], 0, 0, 0); }
    }
}

template <class Src, class Body>
__device__ __forceinline__ void stream(LAS unsigned char* lds, int ntiles, int tid, Src src, Body body, bool pre = false) {
    if (ntiles <= 0) return;
    const int lane = tid & 63, wv = __builtin_amdgcn_readfirstlane(tid >> 6);
    const int row = 8 * wv + (lane >> 3), chs = (lane & 7) ^ ((row >> 1) & 7);
#define NSA_ISSUE(i_) do { const bf16* kp_; const bf16* vp_; int kpi_, vpi_; src((i_), kp_, vp_, kpi_, vpi_); LAS unsigned char* b_ = lds + ((i_) & (NBUF - 1)) * BUF_B + wv * 1024; \
        __builtin_amdgcn_global_load_lds((const unsigned*)(kp_ + (size_t)row * kpi_ + chs * 8), (LAS unsigned*)b_, 16, 0, 0); \
        __builtin_amdgcn_global_load_lds((const unsigned*)(vp_ + (size_t)row * vpi_ + chs * 8), (LAS unsigned*)(b_ + TILE_B), 16, 0, 0); } while (0)
    asm volatile("s_waitcnt vmcnt(0)" ::: "memory");
    if (!pre) { NSA_ISSUE(0); if (ntiles > 1) NSA_ISSUE(1); if (ntiles > 2) NSA_ISSUE(2); }
    for (int i = 0; i < ntiles; ++i) {
        const int ahead = ntiles - 1 - i;
        if (ahead >= 2) asm volatile("s_waitcnt vmcnt(4)" ::: "memory"); else if (ahead == 1) asm volatile("s_waitcnt vmcnt(2)" ::: "memory"); else asm volatile("s_waitcnt vmcnt(0)" ::: "memory");
        __builtin_amdgcn_s_barrier();
        asm volatile("" ::: "memory");
        LAS unsigned char* cur = lds + (i & (NBUF - 1)) * BUF_B;
        body(i, (const LAS unsigned char*)cur, (const LAS unsigned char*)(cur + TILE_B));
        if (i + 3 < ntiles) NSA_ISSUE(i + 3);
    }
    asm volatile("s_waitcnt lgkmcnt(0)" ::: "memory");
    __builtin_amdgcn_s_barrier();
    asm volatile("" ::: "memory");
#undef NSA_ISSUE
}
template <class Src, class Body>
__device__ __forceinline__ void stream2(LAS unsigned char* lds, int ntiles, int tid, Src src, Body body) {
    if (ntiles <= 0) return;
    const int lane = tid & 63, wv = __builtin_amdgcn_readfirstlane(tid >> 6);
    const int row = 8 * wv + (lane >> 3), chs = (lane & 7) ^ ((row >> 1) & 7);
#define NSA_ISSUE2(i_) do { const bf16* kp_; const bf16* vp_; int kpi_, vpi_; src((i_), kp_, vp_, kpi_, vpi_); LAS unsigned char* b_ = lds + ((i_) & (NBUF - 1)) * BUF_B + wv * 1024; \
        __builtin_amdgcn_global_load_lds((const unsigned*)(kp_ + (size_t)row * kpi_ + chs * 8), (LAS unsigned*)b_, 16, 0, 0); \
        __builtin_amdgcn_global_load_lds((const unsigned*)(vp_ + (size_t)row * vpi_ + chs * 8), (LAS unsigned*)(b_ + TILE_B), 16, 0, 0); } while (0)
    asm volatile("s_waitcnt vmcnt(0)" ::: "memory");
    NSA_ISSUE2(0); if (ntiles > 1) NSA_ISSUE2(1); if (ntiles > 2) NSA_ISSUE2(2); if (ntiles > 3) NSA_ISSUE2(3);
    for (int i0 = 0; i0 < ntiles; i0 += 2) {
        if (i0 == 0) { if (ntiles > 3) asm volatile("s_waitcnt vmcnt(4)" ::: "memory"); else if (ntiles > 2) asm volatile("s_waitcnt vmcnt(2)" ::: "memory"); else asm volatile("s_waitcnt vmcnt(0)" ::: "memory"); }
        else asm volatile("s_waitcnt vmcnt(0)" ::: "memory");
        __builtin_amdgcn_s_barrier();
        asm volatile("" ::: "memory");
        if (i0 >= 2) { if (i0 + 2 < ntiles) NSA_ISSUE2(i0 + 2); if (i0 + 3 < ntiles) NSA_ISSUE2(i0 + 3); }
        LAS unsigned char* c0 = lds + (i0 & (NBUF - 1)) * BUF_B; LAS unsigned char* c1 = lds + ((i0 + 1) & (NBUF - 1)) * BUF_B;
        body(i0, (const LAS unsigned char*)c0, (const LAS unsigned char*)(c0 + TILE_B), (const LAS unsigned char*)c1, (const LAS unsigned char*)(c1 + TILE_B), i0 + 1 < ntiles);
    }
    asm volatile("s_waitcnt lgkmcnt(0)" ::: "memory");
    __builtin_amdgcn_s_barrier();
    asm volatile("" ::: "memory");
#undef NSA_ISSUE2
}
template <class Src>
__device__ __forceinline__ void stream_pre(LAS unsigned char* lds, int ntiles, int tid, Src src) {
    const int lane = tid & 63, wv = __builtin_amdgcn_readfirstlane(tid >> 6);
    const int row = 8 * wv + (lane >> 3), chs = (lane & 7) ^ ((row >> 1) & 7);
    for (int i = 0; i < 3 && i < ntiles; ++i) { const bf16* kp_; const bf16* vp_; int kpi_, vpi_; src(i, kp_, vp_, kpi_, vpi_); LAS unsigned char* b_ = lds + (i & (NBUF - 1)) * BUF_B + wv * 1024;
        __builtin_amdgcn_global_load_lds((const unsigned*)(kp_ + (size_t)row * kpi_ + chs * 8), (LAS unsigned*)b_, 16, 0, 0);
        __builtin_amdgcn_global_load_lds((const unsigned*)(vp_ + (size_t)row * vpi_ + chs * 8), (LAS unsigned*)(b_ + TILE_B), 16, 0, 0); }
}

template <int NGR>
__device__ __forceinline__ void visit2(const LAS unsigned char* Ta, const LAS unsigned char* Tb, LAS unsigned char* lds, const bf16x8 (&Q0)[NGR], const bf16x8 (&Q1)[NGR], const int (&q)[NGR], const bool (&valid)[NGR],
                                       const bool (&acta)[NGR], const bool (&actb)[NGR], bool diaga, bool diagb, int col, int fq) {
    LAS unsigned char* arow[NGR]; int sx[NGR]; LAS f32x2* mlp[NGR]; f32x2 ml[NGR]; f32x4 O[NGR][4];
#pragma unroll
    for (int gI = 0; gI < NGR; ++gI) { const int c = 4 * q[gI] + (col & 3); sx[gI] = c & 15; arow[gI] = lds + OFF_ACC + c * 256; mlp[gI] = (LAS f32x2*)(lds + OFF_ML) + c; ml[gI] = *mlp[gI];
#pragma unroll
        for (int dt = 0; dt < 4; ++dt) O[gI][dt] = *(const LAS f32x4*)(arow[gI] + (((4 * dt + fq) ^ sx[gI]) << 4)); }
    f32x4 Sa[NGR][4], Sb[NGR][4];
    const f32x4 zero4 = {0.f, 0.f, 0.f, 0.f};
    bf16x8 ka[8], kb[8];
#pragma unroll
    for (int kt = 0; kt < 4; ++kt) { ka[2 * kt] = *(const LAS bf16x8*)(Ta + swz(16 * kt + col, fq)); ka[2 * kt + 1] = *(const LAS bf16x8*)(Ta + swz(16 * kt + col, 4 + fq)); }
    __builtin_amdgcn_sched_barrier(0);
#pragma unroll
    for (int kt = 0; kt < 4; ++kt) { kb[2 * kt] = *(const LAS bf16x8*)(Tb + swz(16 * kt + col, fq)); kb[2 * kt + 1] = *(const LAS bf16x8*)(Tb + swz(16 * kt + col, 4 + fq)); }
#pragma unroll
    for (int kt = 0; kt < 4; ++kt)
#pragma unroll
        for (int gI = 0; gI < NGR; ++gI) { Sa[gI][kt] = __builtin_amdgcn_mfma_f32_16x16x32_bf16(ka[2 * kt], Q0[gI], zero4, 0, 0, 0); Sa[gI][kt] = __builtin_amdgcn_mfma_f32_16x16x32_bf16(ka[2 * kt + 1], Q1[gI], Sa[gI][kt], 0, 0, 0); }
    __builtin_amdgcn_sched_barrier(0);
#pragma unroll
    for (int kt = 0; kt < 4; ++kt)
#pragma unroll
        for (int gI = 0; gI < NGR; ++gI) { Sb[gI][kt] = __builtin_amdgcn_mfma_f32_16x16x32_bf16(kb[2 * kt], Q0[gI], zero4, 0, 0, 0); Sb[gI][kt] = __builtin_amdgcn_mfma_f32_16x16x32_bf16(kb[2 * kt + 1], Q1[gI], Sb[gI][kt], 0, 0, 0); }
    s16x4 va[16], vb[16];
    if (NGR == 1) {
#pragma unroll
        for (int dt = 0; dt < 4; ++dt)
#pragma unroll
            for (int kp = 0; kp < 2; ++kp) { const int vr0 = 32 * kp + 4 * fq + (col >> 2), vch = 2 * dt + ((col & 3) >> 1), vh = (col & 1) * 8;
                va[4 * dt + 2 * kp] = __builtin_amdgcn_ds_read_tr16_b64_v4i16((LAS s16x4*)(Ta + TILE_B + swz(vr0, vch) + vh)); va[4 * dt + 2 * kp + 1] = __builtin_amdgcn_ds_read_tr16_b64_v4i16((LAS s16x4*)(Ta + TILE_B + swz(vr0 + 16, vch) + vh)); }
#pragma unroll
        for (int dt = 0; dt < 4; ++dt)
#pragma unroll
            for (int kp = 0; kp < 2; ++kp) { const int vr0 = 32 * kp + 4 * fq + (col >> 2), vch = 2 * dt + ((col & 3) >> 1), vh = (col & 1) * 8;
                vb[4 * dt + 2 * kp] = __builtin_amdgcn_ds_read_tr16_b64_v4i16((LAS s16x4*)(Tb + TILE_B + swz(vr0, vch) + vh)); vb[4 * dt + 2 * kp + 1] = __builtin_amdgcn_ds_read_tr16_b64_v4i16((LAS s16x4*)(Tb + TILE_B + swz(vr0 + 16, vch) + vh)); }
    }
    __builtin_amdgcn_sched_barrier(0);
    bf16x8 Pa[NGR][2], Pb[NGR][2]; float alpha[NGR], mnew[NGR], lsum[NGR];
#pragma unroll
    for (int gI = 0; gI < NGR; ++gI) {
        if (diaga) {
#pragma unroll
            for (int kt = 0; kt < 4; ++kt)
#pragma unroll
                for (int j = 0; j < 4; ++j) { const int key = 16 * kt + 4 * fq + j; if (key > q[gI]) Sa[gI][kt][j] = NSA_NEG; } }
        if (diagb) {
#pragma unroll
            for (int kt = 0; kt < 4; ++kt)
#pragma unroll
                for (int j = 0; j < 4; ++j) { const int key = 16 * kt + 4 * fq + j; if (key > q[gI]) Sb[gI][kt][j] = NSA_NEG; } }
        float mxa = fmaxf(fmaxf(Sa[gI][0][0], Sa[gI][0][1]), Sa[gI][0][2]);
        mxa = fmaxf(fmaxf(mxa, Sa[gI][0][3]), Sa[gI][1][0]); mxa = fmaxf(fmaxf(mxa, Sa[gI][1][1]), Sa[gI][1][2]); mxa = fmaxf(fmaxf(mxa, Sa[gI][1][3]), Sa[gI][2][0]);
        mxa = fmaxf(fmaxf(mxa, Sa[gI][2][1]), Sa[gI][2][2]); mxa = fmaxf(fmaxf(mxa, Sa[gI][2][3]), Sa[gI][3][0]); mxa = fmaxf(fmaxf(mxa, Sa[gI][3][1]), Sa[gI][3][2]); mxa = fmaxf(mxa, Sa[gI][3][3]);
        float mxb = fmaxf(fmaxf(Sb[gI][0][0], Sb[gI][0][1]), Sb[gI][0][2]);
        mxb = fmaxf(fmaxf(mxb, Sb[gI][0][3]), Sb[gI][1][0]); mxb = fmaxf(fmaxf(mxb, Sb[gI][1][1]), Sb[gI][1][2]); mxb = fmaxf(fmaxf(mxb, Sb[gI][1][3]), Sb[gI][2][0]);
        mxb = fmaxf(fmaxf(mxb, Sb[gI][2][1]), Sb[gI][2][2]); mxb = fmaxf(fmaxf(mxb, Sb[gI][2][3]), Sb[gI][3][0]); mxb = fmaxf(fmaxf(mxb, Sb[gI][3][1]), Sb[gI][3][2]); mxb = fmaxf(mxb, Sb[gI][3][3]);
        float mx = fmaxf(acta[gI] ? mxa : NSA_NEG, actb[gI] ? mxb : NSA_NEG);
        mx = xmax16(mx); mx = xmax32(mx);
        mnew[gI] = fmaxf(ml[gI][0], mx);
        const float nba = acta[gI] ? -mnew[gI] * LOG2E : NSA_NEG, nbb = actb[gI] ? -mnew[gI] * LOG2E : NSA_NEG;
        alpha[gI] = valid[gI] ? __builtin_amdgcn_exp2f((ml[gI][0] - mnew[gI]) * LOG2E) : 0.f;
        f32x4 ls4 = (f32x4){0.f, 0.f, 0.f, 0.f};
#pragma unroll
        for (int kt = 0; kt < 4; ++kt) { f32x4 a = Sa[gI][kt] * LOG2E + nba;
            a[0] = __builtin_amdgcn_exp2f(a[0]); a[1] = __builtin_amdgcn_exp2f(a[1]); a[2] = __builtin_amdgcn_exp2f(a[2]); a[3] = __builtin_amdgcn_exp2f(a[3]);
            Sa[gI][kt] = a; ls4 = ls4 + a; }
#pragma unroll
        for (int kt = 0; kt < 4; ++kt) { f32x4 a = Sb[gI][kt] * LOG2E + nbb;
            a[0] = __builtin_amdgcn_exp2f(a[0]); a[1] = __builtin_amdgcn_exp2f(a[1]); a[2] = __builtin_amdgcn_exp2f(a[2]); a[3] = __builtin_amdgcn_exp2f(a[3]);
            Sb[gI][kt] = a; ls4 = ls4 + a; }
        lsum[gI] = xsum32(xsum16((ls4[0] + ls4[1]) + (ls4[2] + ls4[3])));
#pragma unroll
        for (int kp = 0; kp < 2; ++kp) { const f32x4 a = Sa[gI][2 * kp], c2 = Sa[gI][2 * kp + 1]; const f32x8 f = {a[0], a[1], a[2], a[3], c2[0], c2[1], c2[2], c2[3]};
            Pa[gI][kp] = __builtin_bit_cast(bf16x8, __builtin_convertvector(f, bf16x8n)); }
#pragma unroll
        for (int kp = 0; kp < 2; ++kp) { const f32x4 a = Sb[gI][2 * kp], c2 = Sb[gI][2 * kp + 1]; const f32x8 f = {a[0], a[1], a[2], a[3], c2[0], c2[1], c2[2], c2[3]};
            Pb[gI][kp] = __builtin_bit_cast(bf16x8, __builtin_convertvector(f, bf16x8n)); }
    }
    if (NGR != 1) {
#pragma unroll
        for (int dt = 0; dt < 4; ++dt)
#pragma unroll
            for (int kp = 0; kp < 2; ++kp) { const int vr0 = 32 * kp + 4 * fq + (col >> 2), vch = 2 * dt + ((col & 3) >> 1), vh = (col & 1) * 8;
                va[4 * dt + 2 * kp] = __builtin_amdgcn_ds_read_tr16_b64_v4i16((LAS s16x4*)(Ta + TILE_B + swz(vr0, vch) + vh)); va[4 * dt + 2 * kp + 1] = __builtin_amdgcn_ds_read_tr16_b64_v4i16((LAS s16x4*)(Ta + TILE_B + swz(vr0 + 16, vch) + vh)); }
#pragma unroll
        for (int dt = 0; dt < 4; ++dt)
#pragma unroll
            for (int kp = 0; kp < 2; ++kp) { const int vr0 = 32 * kp + 4 * fq + (col >> 2), vch = 2 * dt + ((col & 3) >> 1), vh = (col & 1) * 8;
                vb[4 * dt + 2 * kp] = __builtin_amdgcn_ds_read_tr16_b64_v4i16((LAS s16x4*)(Tb + TILE_B + swz(vr0, vch) + vh)); vb[4 * dt + 2 * kp + 1] = __builtin_amdgcn_ds_read_tr16_b64_v4i16((LAS s16x4*)(Tb + TILE_B + swz(vr0 + 16, vch) + vh)); }
    }
    __builtin_amdgcn_sched_barrier(0);
#pragma unroll
    for (int gI = 0; gI < NGR; ++gI)
#pragma unroll
        for (int dt = 0; dt < 4; ++dt) O[gI][dt] = O[gI][dt] * alpha[gI];
#pragma unroll
    for (int dt = 0; dt < 4; ++dt)
#pragma unroll
        for (int kp = 0; kp < 2; ++kp) { const s16x4 v0 = va[4 * dt + 2 * kp], v1 = va[4 * dt + 2 * kp + 1]; const bf16x8 vf = {v0[0], v0[1], v0[2], v0[3], v1[0], v1[1], v1[2], v1[3]};
#pragma unroll
            for (int gI = 0; gI < NGR; ++gI) O[gI][dt] = __builtin_amdgcn_mfma_f32_16x16x32_bf16(vf, Pa[gI][kp], O[gI][dt], 0, 0, 0); }
#pragma unroll
    for (int dt = 0; dt < 4; ++dt)
#pragma unroll
        for (int kp = 0; kp < 2; ++kp) { const s16x4 v0 = vb[4 * dt + 2 * kp], v1 = vb[4 * dt + 2 * kp + 1]; const bf16x8 vf = {v0[0], v0[1], v0[2], v0[3], v1[0], v1[1], v1[2], v1[3]};
#pragma unroll
            for (int gI = 0; gI < NGR; ++gI) O[gI][dt] = __builtin_amdgcn_mfma_f32_16x16x32_bf16(vf, Pb[gI][kp], O[gI][dt], 0, 0, 0); }
#pragma unroll
    for (int gI = 0; gI < NGR; ++gI)
        if (valid[gI]) {
#pragma unroll
            for (int dt = 0; dt < 4; ++dt) *(LAS f32x4*)(arow[gI] + (((4 * dt + fq) ^ sx[gI]) << 4)) = O[gI][dt];
            if (fq == 0) *mlp[gI] = (f32x2){mnew[gI], alpha[gI] * ml[gI][1] + lsum[gI]};
        }
}

__device__ __forceinline__ void attn_unit(LAS unsigned char* lds, int b, int g, int qb, const bf16* __restrict__ q, const bf16* __restrict__ cmp, const bf16* __restrict__ ks, const bf16* __restrict__ vs,
                                          const bf16* __restrict__ kw, const bf16* __restrict__ vw, const float* __restrict__ gates, bf16* __restrict__ o, float* __restrict__ gpark) {
    int tid_raw = threadIdx.x; asm volatile("" : "+v"(tid_raw));
    const int tid = tid_raw, lane = tid & 63, w = __builtin_amdgcn_readfirstlane(tid >> 6), col = lane & 15, fq = lane >> 4;
    const int bg = b * NG_ + g;
    LAS float* Gs = (LAS float*)(lds + OFF_G + w * 4096); LAS float* E3s = (LAS float*)(lds + OFF_E3 + w * 4096);
    LAS unsigned* selm = (LAS unsigned*)(lds + OFF_SEL); LAS unsigned* uni = (LAS unsigned*)(lds + OFF_UNI);
    if (tid < 4) uni[tid] = 0u;
    int tl[2]; size_t tokc[2]; bf16x8 Qf[2][2]; float gt[2][3];
#pragma unroll
    for (int cg = 0; cg < 2; ++cg) { tl[cg] = 8 * w + 4 * cg + (col >> 2); tokc[cg] = (size_t)b * S_ + 64 * qb + tl[cg];
        const bf16* qp = q + tokc[cg] * 1024 + (4 * g + (col & 3)) * 64 + 8 * fq;
        Qf[cg][0] = *(const bf16x8*)qp; Qf[cg][1] = *(const bf16x8*)(qp + 32);
        const float* gp = gates + tokc[cg] * 48 + (4 * g + (col & 3)) * 3; gt[cg][0] = gp[0]; gt[cg][1] = gp[1]; gt[cg][2] = gp[2]; }
    f32x4 Of[2][4];
    const bool both[2] = {true, true};
    float m[2], l[2], invl[2] = {0.f, 0.f}; f32x4 O[2][4];
    {
        const int ncb = (4 * qb + 3 + 63) >> 6;
        const bf16* cbase = cmp + (size_t)bg * NCMP_ * 256;
        int lim[2];
#pragma unroll
        for (int cg = 0; cg < 2; ++cg) { const int t = 64 * qb + tl[cg]; lim[cg] = (t >= 31) ? ((t - 31) >> 4) : -1; m[cg] = NSA_NEG; l[cg] = 0.f; }
        auto src = [&](int i, const bf16*& kp, const bf16*& vp, int& kpi, int& vpi) { kp = cbase + (size_t)(64 * i) * 256; vp = kp + 64; kpi = 256; vpi = 256; };
        stream2(lds, ncb, tid, src, [&](int i0, const LAS unsigned char* K0, const LAS unsigned char* V0, const LAS unsigned char* K1, const LAS unsigned char* V1, bool two) {
            if (two && w < 4 && 64 * (i0 + 1) + 65 <= 4 * qb) { visitw<1>(K0, V0, K1, V1, Qf, m, l, O, invl, Gs, E3s, 0, 0, col, fq); return; }
            for (int i = i0; i < i0 + (two ? 2 : 1); ++i) { const LAS unsigned char* Kt = (i == i0) ? K0 : K1; const LAS unsigned char* Vt = (i == i0) ? V0 : V1;
                const int klo[2] = {0, 0}; const int khi[2] = {lim[0] - 64 * i, lim[1] - 64 * i};
                if (64 * i + 65 > 4 * qb) visit<1, true>(Kt, Vt, both, both, Qf, klo, khi, m, l, O, invl, Gs, E3s, 0, col, fq);
                else visit<1, false>(Kt, Vt, both, both, Qf, klo, khi, m, l, O, invl, Gs, E3s, 0, col, fq); } });
#pragma unroll
        for (int cg = 0; cg < 2; ++cg) { float lt = xsum32(xsum16(l[cg])); invl[cg] = 1.0f / fmaxf(lt, 1e-30f);
#pragma unroll
            for (int dt = 0; dt < 4; ++dt) O[cg][dt] = (f32x4){0.f, 0.f, 0.f, 0.f}; }
        stream2(lds, ncb, tid, src, [&](int i0, const LAS unsigned char* K0, const LAS unsigned char* V0, const LAS unsigned char* K1, const LAS unsigned char* V1, bool two) {
            if (two && w < 4 && 64 * (i0 + 1) + 65 <= 4 * qb) { visitw<2>(K0, V0, K1, V1, Qf, m, l, O, invl, Gs, E3s, 16 * i0, 16 * i0 + 16, col, fq); return; }
            for (int i = i0; i < i0 + (two ? 2 : 1); ++i) { const LAS unsigned char* Kt = (i == i0) ? K0 : K1; const LAS unsigned char* Vt = (i == i0) ? V0 : V1;
                const int klo[2] = {0, 0}; const int khi[2] = {lim[0] - 64 * i, lim[1] - 64 * i};
                if (64 * i + 65 > 4 * qb) visit<2, true>(Kt, Vt, both, both, Qf, klo, khi, m, l, O, invl, Gs, E3s, 16 * i, col, fq);
                else visit<2, false>(Kt, Vt, both, both, Qf, klo, khi, m, l, O, invl, Gs, E3s, 16 * i, col, fq); } });
#pragma unroll
        for (int cg = 0; cg < 2; ++cg)
#pragma unroll
            for (int dt = 0; dt < 4; ++dt) Of[cg][dt] = O[cg][dt] * gt[cg][0];
    }
    f32x4* gp4 = (f32x4*)gpark + w * 512 + lane;
#pragma unroll
    for (int cg = 0; cg < 2; ++cg)
#pragma unroll
        for (int dt = 0; dt < 4; ++dt) gp4[(cg * 4 + dt) * 64] = Of[cg][dt];
    const bf16* kbf = ks + (size_t)bg * S_ * 64; const bf16* vbf = vs + (size_t)bg * S_ * 64;
    const bool dmode = qb < SEL_DENSE_QB;
    auto srcf = [&](int i, const bf16*& kp, const bf16*& vp, int& kpi, int& vpi) { const int n = dmode ? i : (i == 0 ? 0 : qb - 2 + i); kp = kbf + (size_t)n * 4096; vp = vbf + (size_t)n * 4096; kpi = 64; vpi = 64; };
    stream_pre(lds, dmode ? qb + 1 : 3, tid, srcf);
    asm volatile("s_waitcnt lgkmcnt(0)" ::: "memory"); __builtin_amdgcn_wave_barrier();
    {
        unsigned long long mk0[8], mk1[8];
        if (qb < 16) {
#pragma unroll
            for (int q8 = 0; q8 < 8; ++q8) { mk0[q8] = 0ull; mk1[q8] = 0ull; }
        } else {
            const int n0 = lane, n1 = lane + 64, hi = qb - 2;
            const bool c0 = (n0 >= 1 && n0 <= hi), c1 = (n1 <= hi);
            unsigned v0[8], v1[8], thr[8];
#pragma unroll
            for (int q8 = 0; q8 < 8; ++q8) { const float imp0 = Gs[q8 * 128 + n0] + (n0 > 0 ? E3s[q8 * 128 + n0 - 1] : 0.f), imp1 = Gs[q8 * 128 + n1] + E3s[q8 * 128 + n1 - 1];
                v0[q8] = c0 ? (__float_as_uint(imp0) >> 16) : 0u; v1[q8] = c1 ? (__float_as_uint(imp1) >> 16) : 0u; thr[q8] = 0u; }
            for (int bit = 14; bit >= 0; --bit) {
#pragma unroll
                for (int q8 = 0; q8 < 8; ++q8) { const unsigned tst = thr[q8] | (1u << bit);
                    const int cnt = __builtin_popcountll(__ballot(c0 && v0[q8] >= tst)) + __builtin_popcountll(__ballot(c1 && v1[q8] >= tst));
                    if (cnt >= 13) thr[q8] = tst; } }
            const unsigned long long below = (1ull << lane) - 1ull;
#pragma unroll
            for (int q8 = 0; q8 < 8; ++q8) {
                const unsigned long long g0 = __ballot(c0 && v0[q8] > thr[q8]), g1 = __ballot(c1 && v1[q8] > thr[q8]), e0 = __ballot(c0 && v0[q8] == thr[q8]), e1 = __ballot(c1 && v1[q8] == thr[q8]);
                const int need = 13 - (__builtin_popcountll(g0) + __builtin_popcountll(g1));
                const bool t0 = c0 && v0[q8] == thr[q8] && __builtin_popcountll(e0 & below) < need, t1 = c1 && v1[q8] == thr[q8] && (__builtin_popcountll(e0) + __builtin_popcountll(e1 & below)) < need;
                const bool s0 = (c0 && v0[q8] > thr[q8]) || t0, s1 = (c1 && v1[q8] > thr[q8]) || t1;
                mk0[q8] = __ballot(s0); mk1[q8] = __ballot(s1); }
        }
        unsigned long long um0 = 0ull, um1 = 0ull;
#pragma unroll
        for (int q8 = 0; q8 < 8; ++q8) { um0 |= mk0[q8]; um1 |= mk1[q8];
            if (lane == 0) { LAS unsigned* sp = selm + (8 * w + q8) * 4; sp[0] = (unsigned)mk0[q8]; sp[1] = (unsigned)(mk0[q8] >> 32); sp[2] = (unsigned)mk1[q8]; sp[3] = (unsigned)(mk1[q8] >> 32); } }
        if (lane == 0 && !dmode) { __hip_atomic_fetch_or(uni + 0, (unsigned)um0, __ATOMIC_RELAXED, __HIP_MEMORY_SCOPE_WORKGROUP); __hip_atomic_fetch_or(uni + 1, (unsigned)(um0 >> 32), __ATOMIC_RELAXED, __HIP_MEMORY_SCOPE_WORKGROUP);
            __hip_atomic_fetch_or(uni + 2, (unsigned)um1, __ATOMIC_RELAXED, __HIP_MEMORY_SCOPE_WORKGROUP); __hip_atomic_fetch_or(uni + 3, (unsigned)(um1 >> 32), __ATOMIC_RELAXED, __HIP_MEMORY_SCOPE_WORKGROUP); }
    }
    __syncthreads();
    {
        const int ntf = dmode ? qb + 1 : 3;
#pragma unroll
        for (int cg = 0; cg < 2; ++cg) { m[cg] = NSA_NEG; l[cg] = 0.f;
#pragma unroll
            for (int dt = 0; dt < 4; ++dt) O[cg][dt] = (f32x4){0.f, 0.f, 0.f, 0.f}; }
        if (!dmode) {
            asm volatile("s_waitcnt vmcnt(0)" ::: "memory"); __builtin_amdgcn_s_barrier(); asm volatile("" ::: "memory");
            const int klo[2] = {0, 0}; const int khi[2] = {tl[0], tl[1]};
            visitw<0>(lds, lds + TILE_B, lds + BUF_B, lds + BUF_B + TILE_B, Qf, m, l, O, invl, Gs, E3s, 0, 0, col, fq);
            visit<0, true>(lds + 2 * BUF_B, lds + 2 * BUF_B + TILE_B, both, both, Qf, klo, khi, m, l, O, invl, Gs, E3s, 0, col, fq);
            asm volatile("s_waitcnt lgkmcnt(0)" ::: "memory"); __builtin_amdgcn_s_barrier(); asm volatile("" ::: "memory");
        } else
        stream(lds, ntf, tid, srcf, [&](int i, const LAS unsigned char* Kt, const LAS unsigned char* Vt) {
            const int n = dmode ? i : (i == 0 ? 0 : qb - 2 + i); const int klo[2] = {0, 0}; const int khi[2] = {tl[0], tl[1]};
            bool on[2] = {true, true};
            if (qb >= 16 && n >= 1 && n < qb - 1) {
#pragma unroll
                for (int cg = 0; cg < 2; ++cg) on[cg] = ((selm[tl[cg] * 4 + (n >> 5)] >> (n & 31)) & 1u) != 0u; }
            if (n == qb) visit<0, true>(Kt, Vt, both, both, Qf, klo, khi, m, l, O, invl, Gs, E3s, 0, col, fq); else visit<0, false>(Kt, Vt, both, on, Qf, klo, khi, m, l, O, invl, Gs, E3s, 0, col, fq); }, true);
    }
    {
        const unsigned u0 = uni[0], u1 = uni[1], u2 = uni[2], u3 = uni[3];
        const unsigned long long um0 = ((unsigned long long)(unsigned)__builtin_amdgcn_readfirstlane((int)u1) << 32) | (unsigned)__builtin_amdgcn_readfirstlane((int)u0),
                                 um1 = ((unsigned long long)(unsigned)__builtin_amdgcn_readfirstlane((int)u3) << 32) | (unsigned)__builtin_amdgcn_readfirstlane((int)u2);
        const int nsel = __builtin_popcountll(um0) + __builtin_popcountll(um1), nsteps = (nsel + 1) >> 1;
        LAS unsigned* AM = (LAS unsigned*)(lds + OFF_AM); LAS unsigned char* QL = lds + OFF_QL; LAS unsigned* QC = (LAS unsigned*)(lds + OFF_QC); LAS unsigned char* TL = lds + OFF_TL;
        const unsigned long long below = (1ull << lane) - 1ull;
        {
            const unsigned sw = selm[lane * 4 + (w >> 1)] >> (16 * (w & 1));
#pragma unroll
            for (int j = 0; j < 16; ++j) { const unsigned long long bm = __ballot(((sw >> j) & 1u) != 0u); if (lane == 0) { AM[2 * (16 * w + j)] = (unsigned)bm; AM[2 * (16 * w + j) + 1] = (unsigned)(bm >> 32); } }
#pragma unroll
            for (int cg = 0; cg < 2; ++cg) { const int c = 4 * tl[cg] + (col & 3); const float lt = xsum32(xsum16(l[cg]));
#pragma unroll
                for (int dt = 0; dt < 4; ++dt) *(LAS f32x4*)(lds + OFF_ACC + c * 256 + (((4 * dt + fq) ^ (c & 15)) << 4)) = O[cg][dt];
                if (fq == 0) ((LAS f32x2*)(lds + OFF_ML))[c] = (f32x2){m[cg], lt}; }
            if ((um0 >> lane) & 1ull) TL[__builtin_popcountll(um0 & below)] = (unsigned char)lane;
            if ((um1 >> lane) & 1ull) TL[__builtin_popcountll(um0) + __builtin_popcountll(um1 & below)] = (unsigned char)(64 + lane);
        }
        __syncthreads();
        for (int s = w; s < nsteps; s += 8) {
            const int na = TL[2 * s], nb2 = (2 * s + 1 < nsel) ? TL[2 * s + 1] : na;
            const unsigned long long am = ((unsigned long long)(AM[2 * na + 1] | AM[2 * nb2 + 1]) << 32) | (unsigned long long)(AM[2 * na] | AM[2 * nb2]);
            if ((am >> lane) & 1ull) QL[s * 64 + __builtin_popcountll(am & below)] = (unsigned char)lane;
            if (lane == 0) { const unsigned cnt = (unsigned)__builtin_popcountll(am); const bool hb = 2 * s + 1 < nsel; QC[s] = cnt;
                LAS unsigned* rec = (LAS unsigned*)(lds + OFF_REC) + 8 * s;
                rec[0] = AM[2 * na]; rec[1] = AM[2 * na + 1]; rec[2] = hb ? AM[2 * nb2] : 0u; rec[3] = hb ? AM[2 * nb2 + 1] : 0u; rec[4] = (unsigned)na | ((unsigned)nb2 << 8) | (cnt << 16) | (hb ? (1u << 24) : 0u); }
        }
        __syncthreads();
        const bf16* kb = ks + (size_t)bg * S_ * 64; const bf16* vb = vs + (size_t)bg * S_ * 64;
        const int drow = 8 * w + (lane >> 3), dchs = (lane & 7) ^ ((drow >> 1) & 7);
        const LAS unsigned* REC = (const LAS unsigned*)(lds + OFF_REC);
        auto issue = [&](int s, unsigned info) {
            const int na = __builtin_amdgcn_readfirstlane((int)(info & 0xffu)), nb2 = __builtin_amdgcn_readfirstlane((int)((info >> 8) & 0xffu));
            LAS unsigned char* base = lds + (s & 1) * 2 * BUF_B + w * 1024;
            __builtin_amdgcn_global_load_lds((const unsigned*)(kb + (size_t)na * 4096 + drow * 64 + dchs * 8), (LAS unsigned*)base, 16, 0, 0);
            __builtin_amdgcn_global_load_lds((const unsigned*)(vb + (size_t)na * 4096 + drow * 64 + dchs * 8), (LAS unsigned*)(base + TILE_B), 16, 0, 0);
            __builtin_amdgcn_global_load_lds((const unsigned*)(kb + (size_t)nb2 * 4096 + drow * 64 + dchs * 8), (LAS unsigned*)(base + BUF_B), 16, 0, 0);
            __builtin_amdgcn_global_load_lds((const unsigned*)(vb + (size_t)nb2 * 4096 + drow * 64 + dchs * 8), (LAS unsigned*)(base + BUF_B + TILE_B), 16, 0, 0); };
        auto lookup = [&](int s, int gi, int& qv, bool& vl) { const int cnt = (int)QC[s]; const int rank = 4 * gi + (col >> 2); vl = rank < cnt; qv = vl ? (int)QL[s * 64 + rank] : 0; };
        auto qload = [&](int qv, bf16x8& A, bf16x8& B) { const bf16* qp = q + ((size_t)b * S_ + 64 * qb + qv) * 1024 + (4 * g + (col & 3)) * 64 + 8 * fq; A = *(const bf16x8*)qp; B = *(const bf16x8*)(qp + 32); };
        if (nsteps > 0) {
        const int rk = 4 * w + (col >> 2);
        u32x4 mkc = *(const LAS u32x4*)(REC), mkn; unsigned infc = REC[4], infn; int qin;
        int qn0 = (int)QL[rk]; bool vn0 = rk < (int)((infc >> 16) & 0xffu); qn0 = vn0 ? qn0 : 0;
        bf16x8 QnA0, QnB0;
        asm volatile("s_waitcnt vmcnt(0)" ::: "memory");
        qload(qn0, QnA0, QnB0);
        issue(0, infc);
        { const int s1 = nsteps > 1 ? 1 : 0; mkn = *(const LAS u32x4*)(REC + 8 * s1); infn = REC[8 * s1 + 4]; qin = (int)QL[s1 * 64 + rk]; }
        for (int s = 0; s < nsteps; ++s) {
            asm volatile("s_waitcnt vmcnt(0) lgkmcnt(0)" ::: "memory");
            __builtin_amdgcn_s_barrier();
            asm volatile("" ::: "memory");
            const int qc0 = qn0; const bool vc0 = vn0; const bf16x8 QA0 = QnA0, QB0 = QnB0;
            if (s + 1 < nsteps) { vn0 = rk < (int)((infn >> 16) & 0xffu); qn0 = vn0 ? qin : 0; qload(qn0, QnA0, QnB0); issue(s + 1, infn); }
            const unsigned long long ama = ((unsigned long long)(unsigned)__builtin_amdgcn_readfirstlane((int)mkc.y) << 32) | (unsigned)__builtin_amdgcn_readfirstlane((int)mkc.x);
            const unsigned long long amb = ((unsigned long long)(unsigned)__builtin_amdgcn_readfirstlane((int)mkc.w) << 32) | (unsigned)__builtin_amdgcn_readfirstlane((int)mkc.z);
            const unsigned infu = (unsigned)__builtin_amdgcn_readfirstlane((int)infc);
            const int na = (int)(infu & 0xffu), nb2 = (int)((infu >> 8) & 0xffu), cnt = (int)((infu >> 16) & 0xffu); const bool has_b = (infu >> 24) != 0u;
            const LAS unsigned char* Ta = lds + (s & 1) * 2 * BUF_B; const LAS unsigned char* Tb = Ta + BUF_B;
            if (4 * (w + 8) < cnt) {
                int qv1; bool vl1; bf16x8 QA1, QB1; lookup(s, w + 8, qv1, vl1); qload(qv1, QA1, QB1);
                const bf16x8 Q0g[2] = {QA0, QA1}, Q1g[2] = {QB0, QB1}; const int qg[2] = {qc0, qv1}; const bool vg[2] = {vc0, vl1};
                const bool aa[2] = {vc0 && ((ama >> qc0) & 1ull) != 0ull, vl1 && ((ama >> qv1) & 1ull) != 0ull}, ab[2] = {vc0 && ((amb >> qc0) & 1ull) != 0ull, vl1 && ((amb >> qv1) & 1ull) != 0ull};
                visit2<2>(Ta, Tb, lds, Q0g, Q1g, qg, vg, aa, ab, na == qb, has_b && nb2 == qb, col, fq);
            } else if (4 * w < cnt) {
                const bf16x8 Q0g[1] = {QA0}, Q1g[1] = {QB0}; const int qg[1] = {qc0}; const bool vg[1] = {vc0};
                const bool aa[1] = {vc0 && ((ama >> qc0) & 1ull) != 0ull}, ab[1] = {vc0 && ((amb >> qc0) & 1ull) != 0ull};
                visit2<1>(Ta, Tb, lds, Q0g, Q1g, qg, vg, aa, ab, na == qb, has_b && nb2 == qb, col, fq);
            }
            mkc = mkn; infc = infn;
            { const int s2 = s + 2 < nsteps ? s + 2 : nsteps - 1; mkn = *(const LAS u32x4*)(REC + 8 * s2); infn = REC[8 * s2 + 4]; qin = (int)QL[s2 * 64 + rk]; }
        }
        }
        asm volatile("s_waitcnt lgkmcnt(0)" ::: "memory");
        __builtin_amdgcn_s_barrier();
        asm volatile("" ::: "memory");
        asm volatile("" : "+v"(tl[0]), "+v"(tl[1]));
#pragma unroll
        for (int cg = 0; cg < 2; ++cg) tokc[cg] = (size_t)b * S_ + 64 * qb + tl[cg];
        int lane_o = lane; asm volatile("" : "+v"(lane_o));
        const f32x4* gp4o = (const f32x4*)gpark + w * 512 + lane_o;
#pragma unroll
        for (int cg = 0; cg < 2; ++cg) { const bf16* qp = q + tokc[cg] * 1024 + (4 * g + (col & 3)) * 64 + 8 * fq; Qf[cg][0] = *(const bf16x8*)qp; Qf[cg][1] = *(const bf16x8*)(qp + 32);
            const float* gp = gates + tokc[cg] * 48 + (4 * g + (col & 3)) * 3; gt[cg][1] = gp[1]; gt[cg][2] = gp[2]; }
#pragma unroll
        for (int cg = 0; cg < 2; ++cg) { const int c = 4 * tl[cg] + (col & 3); const f32x2 ml = ((const LAS f32x2*)(lds + OFF_ML))[c]; const float sc = gt[cg][1] / fmaxf(ml[1], 1e-30f);
#pragma unroll
            for (int dt = 0; dt < 4; ++dt) Of[cg][dt] = gp4o[(cg * 4 + dt) * 64] + *(const LAS f32x4*)(lds + OFF_ACC + c * 256 + (((4 * dt + fq) ^ (c & 15)) << 4)) * sc; }
        __syncthreads();
    }
    LAS f32x4* park = (LAS f32x4*)(lds + OFF_G + w * 8192) + lane;
#pragma unroll
    for (int cg = 0; cg < 2; ++cg)
#pragma unroll
        for (int dt = 0; dt < 4; ++dt) park[(cg * 4 + dt) * 64] = Of[cg][dt];
    {
        const int nb0 = qb >= 8 ? qb - 8 : 0, nwin = qb - nb0 + 1;
#pragma unroll
        for (int cg = 0; cg < 2; ++cg) { m[cg] = NSA_NEG; l[cg] = 0.f;
#pragma unroll
            for (int dt = 0; dt < 4; ++dt) O[cg][dt] = (f32x4){0.f, 0.f, 0.f, 0.f}; }
        const bf16* kb = kw + (size_t)bg * S_ * 64; const bf16* vb = vw + (size_t)bg * S_ * 64;
        auto src = [&](int i, const bf16*& kp, const bf16*& vp, int& kpi, int& vpi) { kp = kb + (size_t)(nb0 + i) * 64 * 64; vp = vb + (size_t)(nb0 + i) * 64 * 64; kpi = 64; vpi = 64; };
        stream2(lds, nwin, tid, src, [&](int i0, const LAS unsigned char* K0, const LAS unsigned char* V0, const LAS unsigned char* K1, const LAS unsigned char* V1, bool two) {
            { const int n0 = nb0 + i0; if (two && w < 4 && n0 != qb - 8 && n0 + 1 != qb) { visitw<0>(K0, V0, K1, V1, Qf, m, l, O, invl, Gs, E3s, 0, 0, col, fq); return; } }
            for (int i = i0; i < i0 + (two ? 2 : 1); ++i) { const LAS unsigned char* Kt = (i == i0) ? K0 : K1; const LAS unsigned char* Vt = (i == i0) ? V0 : V1;
                const int n = nb0 + i; int klo[2], khi[2];
#pragma unroll
                for (int cg = 0; cg < 2; ++cg) { klo[cg] = (n == qb - 8) ? tl[cg] + 1 : 0; khi[cg] = (n == qb) ? tl[cg] : 63; }
                if (n == qb || n == qb - 8) visit<0, true>(Kt, Vt, both, both, Qf, klo, khi, m, l, O, invl, Gs, E3s, 0, col, fq); else visit<0, false>(Kt, Vt, both, both, Qf, klo, khi, m, l, O, invl, Gs, E3s, 0, col, fq); } });
#pragma unroll
        for (int cg = 0; cg < 2; ++cg) { float lt = xsum32(xsum16(l[cg])); const float sc = gt[cg][2] / fmaxf(lt, 1e-30f);
#pragma unroll
            for (int dt = 0; dt < 4; ++dt) O[cg][dt] = park[(cg * 4 + dt) * 64] + O[cg][dt] * sc; }
    }
#pragma unroll
    for (int cg = 0; cg < 2; ++cg) { bf16* op = o + tokc[cg] * 1024 + (4 * g + (col & 3)) * 64 + 4 * fq;
#pragma unroll
        for (int dt = 0; dt < 4; ++dt) { uint2 wv; wv.x = pk_bf16(O[cg][dt][0], O[cg][dt][1]); wv.y = pk_bf16(O[cg][dt][2], O[cg][dt][3]); *(uint2*)(op + 16 * dt) = wv; } }
}
__device__ __forceinline__ void attn_phase(LAS unsigned char* lds, const bf16* __restrict__ q, const bf16* __restrict__ cmp, const bf16* __restrict__ ks, const bf16* __restrict__ vs, const bf16* __restrict__ kw,
                                           const bf16* __restrict__ vw, const float* __restrict__ gates, bf16* __restrict__ o, float* __restrict__ gpark, int G, int bid) {
    const int nunit = NB_ * NG_ * (S_ / 64);
    for (int i = 0, L = bid; L < nunit; ++i, L += G) {
        const int Lc = ((i & 1) && (nunit % G) == 0) ? (L - bid) + (G - 1 - bid) : L;
        const int qb = (S_ / 64) - 1 - Lc / 16, bg = Lc & 15;
        attn_unit(lds, bg >> 2, bg & 3, qb, q, cmp, ks, vs, kw, vw, gates, o, gpark + (size_t)bid * 16384);
        __syncthreads();
    }
}
}
#define XB_TMO      128
#define XB_XCNT(j)  (256  + 64 * (j))
#define XB_XSUB(j)  (1280 + 64 * (j))
#define XB_XGEN(j)  (2304 + 64 * (j))
#define XB_TOP      3328
#define XB_TOPGEN   3392
#define XCD_BAR_WORDS 3456
#define XB_SPIN_CAP (1u << 18)

__device__ __forceinline__ unsigned xb_ld(unsigned* p)              { return __hip_atomic_load(p, __ATOMIC_RELAXED, __HIP_MEMORY_SCOPE_AGENT); }
__device__ __forceinline__ unsigned xb_add(unsigned* p, unsigned v) { return __hip_atomic_fetch_add(p, v, __ATOMIC_RELAXED, __HIP_MEMORY_SCOPE_AGENT); }
__device__ __forceinline__ unsigned xb_xcc_id() { return (unsigned)__builtin_amdgcn_s_getreg((3 << 11) | 20) & 0xFu; }
#define XB_SPIN(cond, bar) do { unsigned _sp = 0; while (cond) { __builtin_amdgcn_s_sleep(1); \
    if ((++_sp & 255u) == 0u) { if (xb_ld(&(bar)[XB_TMO])) break; if (_sp > XB_SPIN_CAP) { atomicAdd(&(bar)[XB_TMO], 1u); break; } } } } while (0)

struct XcdBarrier {
    unsigned* bar; unsigned x;
    volatile LAS unsigned* st;
};

__device__ __forceinline__ XcdBarrier xcd_barrier_post(unsigned* bar, volatile LAS unsigned* st) {
    XcdBarrier b; b.bar = bar; b.x = xb_xcc_id(); b.st = st;
    if (threadIdx.x == 0) (void)xb_add(&bar[XB_XCNT(b.x)], 1u);
    return b;
}
__device__ __forceinline__ void xcd_barrier_complete(unsigned* bar, unsigned x, unsigned& nloc, unsigned& nx) {
    const unsigned G = gridDim.x * gridDim.y * gridDim.z;
    unsigned sum, cnt, mine, sp = 0u;
    for (;;) {
        sum = 0u; cnt = 0u; mine = 0u;
#pragma unroll
        for (unsigned j = 0; j < 16; ++j) { const unsigned c = xb_ld(&bar[XB_XCNT(j)]); sum += c; cnt += (c > 0u) ? 1u : 0u; mine = (j == x) ? c : mine; }
        if (sum == G) break;
        __builtin_amdgcn_s_sleep(1);
        if ((++sp & 255u) == 0u) { if (xb_ld(&bar[XB_TMO])) break; if (sp > XB_SPIN_CAP) { atomicAdd(&bar[XB_TMO], 1u); break; } }
    }
    nloc = mine > 0u ? mine : 1u; nx = cnt > 0u ? cnt : 1u;
}

__device__ __forceinline__ void xcd_barrier(const XcdBarrier& b) {
    asm volatile("s_waitcnt vmcnt(0)" ::: "memory");
    __syncthreads();
    if (threadIdx.x == 0) {
        unsigned* bar = b.bar;
        __builtin_amdgcn_s_waitcnt(0);
        unsigned nloc = b.st[0], nx = b.st[1];
        if (nloc == 0u) { xcd_barrier_complete(bar, b.x, nloc, nx); b.st[0] = nloc; b.st[1] = nx; }
        const unsigned old = xb_add(&bar[XB_XSUB(b.x)], 1u);
        const unsigned gen = old / nloc;
        if (old + 1u == (gen + 1u) * nloc) {
            __builtin_amdgcn_fence(__ATOMIC_RELEASE, "agent");
            asm volatile("s_waitcnt vmcnt(0)" ::: "memory");
            const unsigned og = xb_add(&bar[XB_TOP], 1u);
            const unsigned tg = og / nx;
            if (og + 1u == (tg + 1u) * nx) xb_add(&bar[XB_TOPGEN], 1u);
            else XB_SPIN(xb_ld(&bar[XB_TOPGEN]) == tg, bar);
            __builtin_amdgcn_fence(__ATOMIC_ACQUIRE, "agent");
            xb_add(&bar[XB_XGEN(b.x)], 1u);
            asm volatile("s_waitcnt vmcnt(0)" ::: "memory");
        } else {
            XB_SPIN(xb_ld(&bar[XB_XGEN(b.x)]) == gen, bar);
            __builtin_amdgcn_fence(__ATOMIC_ACQUIRE, "agent");
            asm volatile("s_waitcnt vmcnt(0)" ::: "memory");
        }
    }
    __syncthreads();
}


constexpr size_t MiB = (size_t)1 << 20;
constexpr size_t O_WLIN = 0, O_WLOUT = 6 * MiB, O_WFGU = 9 * MiB, O_WFD = 23 * MiB, O_WNIN = 30 * MiB, O_WNOUT = 36 * MiB, O_WC1K = 38 * MiB, O_WC1V = 39 * MiB, O_WC2 = 40 * MiB,
                 O_WMGU = 41 * MiB, O_WMD = 55 * MiB, O_TAB = 62 * MiB;
constexpr size_t O_HB = 64 * MiB, O_BIG = 128 * MiB, O_Y = 352 * MiB;
constexpr size_t O_Q = 352 * MiB, O_KC = 416 * MiB, O_VC = 432 * MiB, O_KS = 448 * MiB, O_VS = 464 * MiB, O_KW = 480 * MiB, O_VW = 496 * MiB, O_HC = 513 * MiB, O_CMP = 521 * MiB;
constexpr size_t O_RG = 525 * MiB, O_NG = 526 * MiB, O_BIAS1 = 532 * MiB, O_CTL = 533 * MiB, CTL_BYTES = 64 * 1024, O_RSQ = 534 * MiB  , WS_NEED = 538 * MiB;
constexpr size_t O_MW = 128 * MiB, MW_STRIDE = 21 * MiB, O_HID = 275 * MiB, HID_ELEMS = (size_t)72 * 256 * FF_, O_IDX = 21 * MiB, O_WROW = 23 * MiB; constexpr int MCAP = 32768;
constexpr float MOE_SA = 16.0f, MOE_SW = 512.0f, MOE_SH = 8.0f, MOE_SWD = 1024.0f;
constexpr int LDS_BYTES = 163840, MISC_OFF = 159744;

struct Params { const float* in[27]; float* out; unsigned char* ws; };
__device__ __forceinline__ void* karg(int i) {
    const __attribute__((address_space(4))) unsigned char* ka = (const __attribute__((address_space(4))) unsigned char*)__builtin_amdgcn_kernarg_segment_ptr();
    int off = i * 8; asm volatile("" : "+s"(off));
    return *(void* const __attribute__((address_space(4)))*)(ka + off);
}

__global__ void __launch_bounds__(NTHR, 2) mega(Params p) {
    extern __shared__ __attribute__((aligned(16))) unsigned char lds_raw[];
    LAS unsigned char* lds = (LAS unsigned char*)lds_raw;
    const int tid = otid(), G = (int)gridDim.x, bid = (int)blockIdx.x;
    volatile LAS unsigned* MISC = (volatile LAS unsigned*)(lds + MISC_OFF);
    if (tid < 16) MISC[tid] = 0u;
    __syncthreads();
    XcdBarrier bar = xcd_barrier_post((unsigned*)((unsigned char*)karg(28) + O_CTL), MISC);
#define IN(i) ((const float*)karg(i))
#define x IN(0)
#define norm_mix IN(1)
#define norm_ffn IN(2)
#define norm_final IN(3)
#define lru_w_in IN(4)
#define lru_b_in IN(5)
#define conv_w IN(6)
#define conv_b IN(7)
#define w_a IN(8)
#define b_a IN(9)
#define w_i IN(10)
#define b_i IN(11)
#define lam IN(12)
#define lru_w_out IN(13)
#define lru_b_out IN(14)
#define nsa_w_in IN(15)
#define cmp_pe IN(16)
#define cmp_w1 IN(17)
#define cmp_w2 IN(18)
#define nsa_w_out IN(19)
#define ffn_wg IN(20)
#define ffn_wu IN(21)
#define ffn_wd IN(22)
#define w_router IN(23)
#define moe_wg IN(24)
#define moe_wu IN(25)
#define moe_wd IN(26)
#define WSB(off) ((bf16*)((unsigned char*)karg(28) + (off)))
#define WLIN WSB(O_WLIN)
#define WLOUT WSB(O_WLOUT)
#define WFGU WSB(O_WFGU)
#define WFD WSB(O_WFD)
#define WNIN WSB(O_WNIN)
#define WNOUT WSB(O_WNOUT)
#define WC1K WSB(O_WC1K)
#define WC1V WSB(O_WC1V)
#define WC2 WSB(O_WC2)
#define WMGU WSB(O_WMGU)
#define WMD WSB(O_WMD)
#define TAB ((float2*)((unsigned char*)karg(28) + O_TAB))
#define HB ((bf16*)karg(27))
#define SB WSB(O_HB)
#define BIG WSB(O_BIG)
#define Y WSB(O_Y)
#define Q WSB(O_Q)
#define KC WSB(O_KC)
#define VC WSB(O_VC)
#define KS WSB(O_KS)
#define VS WSB(O_VS)
#define KW WSB(O_KW)
#define VW WSB(O_VW)
#define HC WSB(O_HC)
#define CMP WSB(O_CMP)
#define RG ((float*)((unsigned char*)karg(28) + O_RG))
#define NGT ((float*)((unsigned char*)karg(28) + O_NG))
#define BIAS1 ((float*)((unsigned char*)karg(28) + O_BIAS1))
#define out ((float*)karg(27))
#define MCNT ((int*)((unsigned char*)karg(28) + O_CTL + 32768))
#define RS0 ((float*)((unsigned char*)karg(28) + O_RSQ + 3 * MiB))
#define RSQ1 ((float*)((unsigned char*)karg(28) + O_RSQ))
#define RSQ2 ((float*)((unsigned char*)karg(28) + O_RSQ + 2 * MiB))
#define MIDX ((int*)((unsigned char*)karg(28) + O_IDX))
#define MWROW ((float*)((unsigned char*)karg(28) + O_WROW))
    const int BIGN = 1 << 30;
    LAS float* scr = (LAS float*)lds;
#define GRID_BAR() xcd_barrier(bar)
#define MOE_CONV(e_, G_, b_) do { bf16* wgu_ = ((e_) == 7) ? WSB(0) : WSB(O_MW + (size_t)(e_) * MW_STRIDE); bf16* wd_ = (bf16*)((unsigned char*)wgu_ + (size_t)2 * FF_ * D_); \
        convT_job<true>(scr, moe_wg + (size_t)(e_) * D_ * FF_, wgu_, D_, FF_, FF_, D_, 0, 128, 256, 0, (G_), (b_), MOE_SW); convT_job<true>(scr, moe_wu + (size_t)(e_) * D_ * FF_, wgu_, D_, FF_, FF_, D_, 0, 128, 256, 128, (G_), (b_), MOE_SW); \
        convT_job<true>(scr, moe_wd + (size_t)(e_) * FF_ * D_, wd_, FF_, D_, D_, FF_, 0, BIGN, 0, 0, (G_), (b_), MOE_SWD); } while (0)
#define GEMM(EPI, Aptr, Bptr, M_, N_, K_, LDA_, LDB_, E_) do { pg8::Gemm g_; g_.A = (Aptr); g_.Bt = (Bptr); g_.M = (M_); g_.N = (N_); g_.K = (K_); g_.lda = (LDA_); g_.ldb = (LDB_); g_.pad = 0; \
        pg8::StaticOrder S_o; S_o.init((M_), (N_), G, bid); pg8::gemm_phase<EPI, pg8::StaticOrder, true, true>(lds, g_, S_o, (E_)); } while (0)

    convT_job(scr, lru_w_in, WLIN, D_, 2 * DR_, 2 * DR_, D_, 0, BIGN, 0, 0, G, bid, 1.0f, norm_mix);
    convT_job(scr, lru_w_out, WLOUT, DR_, D_, D_, DR_, 0, BIGN, 0, 0, G, bid);
    for (int i = bid * NTHR + otid(); i < 256 * 512; i += G * NTHR) { const int r = i >> 9, k = i & 511; float v = 0.f;
        if (r < 64 && k < 256) v = cmp_w2[(size_t)k * 64 + r]; else if (r >= 64 && r < 128 && k >= 256) v = cmp_w2[(size_t)256 * 64 + (size_t)(k - 256) * 64 + (r - 64)];
        WC2[i] = f2bf(v); }
    rope_table_part(TAB, G, bid);
    pebias_part(scr, cmp_pe, cmp_w1, BIAS1, G, bid);
    cast_rows(x, SB, RS0, G, bid);
    GRID_BAR();
    { pg8::EpiBf16G E; E.O = BIG; E.bias = lru_b_in; E.rsv = RS0; E.ldc = 2 * DR_; E.gelu_cols = DR_; GEMM(pg8::EpiBf16G, SB, WLIN, T_, 2 * DR_, D_, D_, D_, E); }
    if (2 * bid >= G) {
        const int G2 = G - (G + 1) / 2, b2 = bid - (G + 1) / 2;
        convT_job(scr, ffn_wg, WFGU, D_, FF_, FF_, D_, 0, 128, 256, 0, G2, b2, 1.0f, norm_ffn);
        convT_job(scr, ffn_wu, WFGU, D_, FF_, FF_, D_, 0, 128, 256, 128, G2, b2, 1.0f, norm_ffn);
        convT_job(scr, ffn_wd, WFD, FF_, D_, D_, FF_, 0, BIGN, 0, 0, G2, b2);
        convT_job(scr, nsa_w_in, WNIN, D_, NSA_IN_, NSA_PAD_, D_, 0, -1, 0, 0, G2, b2, 1.0f, norm_mix + D_);
        convT_job(scr, nsa_w_out, WNOUT, D_, D_, D_, D_, 0, BIGN, 0, 0, G2, b2);
        convT_job(scr, cmp_w1, WC1K, 2048, 256, 256, 2048, 0, BIGN, 0, 0, G2, b2);
        convT_job(scr, cmp_w1 + (size_t)2048 * 256, WC1V, 2048, 256, 256, 2048, 0, BIGN, 0, 0, G2, b2);
    }
    GRID_BAR();
    for (int u = bid; u < NB_ * NBLK_ * 4; u += G) { lru::lru_unit(lds, u, BIG, conv_w, conv_b, w_a, b_a, w_i, b_i, lam, Y); __syncthreads(); }
    GRID_BAR();
    { pg8::EpiResidB<false> E; E.R = SB; E.X = SB; E.bias = lru_b_out; E.rsq = RSQ1; E.xch = (LAS float*)(lds + 131072); E.ldc = D_; GEMM(pg8::EpiResidB<false>, Y, WLOUT, T_, D_, DR_, DR_, DR_, E); }
    GRID_BAR();
    { pg8::EpiSwiGLU E; E.H = BIG; E.rsq = RSQ1; E.ldc = FF_; E.pad = 0; GEMM(pg8::EpiSwiGLU, SB, WFGU, T_, 2 * FF_, D_, D_, D_, E); }
    GRID_BAR();
    { pg8::EpiResidB<false> E; E.R = SB; E.X = SB; E.bias = nullptr; E.rsq = RSQ2; E.xch = (LAS float*)(lds + 131072); E.ldc = D_; GEMM(pg8::EpiResidB<false>, BIG, WFD, T_, D_, FF_, FF_, FF_, E); }
    GRID_BAR();
    { pg8::EpiNsa E; E.pQ = Q; E.pKC = KC; E.pVC = VC; E.pKS = KS; E.pVS = VS; E.pKW = KW; E.pVW = VW; E.gates = NGT; E.tab = (const float*)TAB; E.rsq = RSQ2; GEMM(pg8::EpiNsa, SB, WNIN, T_, NSA_PAD_, D_, D_, D_, E); }
    if (2 * bid >= G) { const int G2 = G - (G + 1) / 2, b2 = bid - (G + 1) / 2; MOE_CONV(0, G2, b2); MOE_CONV(1, G2, b2); }
    GRID_BAR();
    { pg8::EpiBf16G E; E.O = HC; E.bias = BIAS1; E.rsv = nullptr; E.ldc = 512; E.gelu_cols = 1 << 30; GEMM(pg8::EpiBf16G, KC, WC1K, 16 * NCMP_, 256, 2048, 1024, 2048, E); }
    { pg8::EpiBf16G E; E.O = HC + 256; E.bias = BIAS1 + 256; E.rsv = nullptr; E.ldc = 512; E.gelu_cols = 1 << 30; pg8::Gemm g_; g_.A = VC; g_.Bt = WC1V; g_.M = 16 * NCMP_; g_.N = 256; g_.K = 2048; g_.lda = 1024; g_.ldb = 2048; g_.pad = 0;
      pg8::StaticOrder S_o; S_o.init(16 * NCMP_, 256, G, (bid + G - 32) % G); pg8::gemm_phase<pg8::EpiBf16G, pg8::StaticOrder, true, true>(lds, g_, S_o, E); }
    if (bid >= 64 && G > 64) { for (int e = 2; e < 7; ++e) MOE_CONV(e, G - 64, bid - 64); }
    GRID_BAR();
    { pg8::EpiBf16G E; E.O = CMP; E.bias = nullptr; E.rsv = nullptr; E.ldc = 256; E.gelu_cols = 0; GEMM(pg8::EpiBf16G, HC, WC2, 16 * NCMP_, 256, 512, 512, 512, E); }
    GRID_BAR();
    nsa::attn_phase(lds, Q, CMP, KS, VS, KW, VW, NGT, HB, (float*)KC  , G, bid);
    GRID_BAR();
    { pg8::EpiResidB<false> E; E.R = SB; E.X = SB; E.bias = nullptr; E.rsq = nullptr; E.xch = (LAS float*)(lds + 131072); E.ldc = D_; GEMM(pg8::EpiResidB<false>, HB, WNOUT, T_, D_, D_, D_, D_, E); }
    GRID_BAR();
    if (G <= 64) { for (int e = 2; e < 7; ++e) MOE_CONV(e, G, bid); }
    MOE_CONV(7, G, bid);
    norm_route_rows(lds, SB, norm_ffn + D_, HB, w_router, MCNT, MIDX, MWROW, MCAP, G, bid);
    GRID_BAR();
    {
        LAS unsigned* tt0 = (LAS unsigned*)(lds + MISC_OFF + 64); LAS unsigned* tt1 = tt0 + 256;
        pg8::moe_build_table(tt0, MCNT, 0); pg8::moe_build_table(tt1, MCNT, 1);
        __syncthreads();
        const int NT0 = __builtin_amdgcn_readfirstlane((int)tt0[255]), NT1 = __builtin_amdgcn_readfirstlane((int)tt1[255]);
        const int n0 = NT0 < 64 ? NT0 : 64, n3 = NT1 < 64 ? NT1 : 64;
        for (int ph = 0; ph < 5; ++ph) {
            const int sd = ph - 1, sg = ph;
            const int kd = sd >> 1, kg = sg >> 1;
            const int td0 = (sd == 0) ? 0 : (sd == 1 ? n0 : (sd == 2 ? 0 : NT1 - n3)), tdn = (sd < 0) ? 0 : ((sd == 0) ? n0 : (sd == 1 ? NT0 - n0 : (sd == 2 ? NT1 - n3 : n3)));
            const int tg0 = (sg == 0) ? 0 : (sg == 1 ? n0 : (sg == 2 ? 0 : NT1 - n3)), tgn = (sg > 3) ? 0 : ((sg == 0) ? n0 : (sg == 1 ? NT0 - n0 : (sg == 2 ? NT1 - n3 : n3)));
            const int nd = tdn * (D_ / 256), ng = tgn * (2 * FF_ / 256);
            const int extra = nd > G ? nd - G : 0;
            const int dj0 = bid, dj1 = nd, gj0 = (bid + G - extra) % G, gj1 = ng;
            unsigned char* Hd = (unsigned char*)WSB(O_HID) + (size_t)((sd & 1) ? 1 : 0) * HID_ELEMS; unsigned char* Hg = (unsigned char*)WSB(O_HID) + (size_t)((sg & 1) ? 1 : 0) * HID_ELEMS;
            if (sd >= 0 && dj1 > dj0) { pg8::MoeSched S_m; S_m.init(kd ? tt1 : tt0, MIDX, MCAP, kd, D_ / 256, td0, tdn, dj0, dj1, G); pg8::EpiMoeDown E; E.X = SB; E.idx = MIDX; E.wrow = MWROW; E.ldc = D_; E.cap = MCAP; E.inv = 1.0f / (MOE_SH * MOE_SWD); E.pad = 0;
                pg8::gemm_phase2<pg8::EpiMoeDown, false, true>(lds, (const bf16*)Hd, FF_ / 2, (const bf16*)((unsigned char*)WSB(O_MW) + (size_t)2 * FF_ * D_), (const bf16*)((unsigned char*)WSB(0) + (size_t)2 * FF_ * D_), FF_ / 2, MW_STRIDE, FF_ / 2, S_m, E); }
            if (sg <= 3 && gj1 > gj0) { pg8::MoeSched S_m; S_m.init(kg ? tt1 : tt0, MIDX, MCAP, kg, 2 * FF_ / 256, tg0, tgn, gj0, gj1, G); pg8::EpiSwiGLU2F8 E; E.H = Hg; E.ldc = FF_; E.inv = 1.0f / (MOE_SA * MOE_SW); E.oscale = MOE_SH; E.pad = 0;
                pg8::gemm_phase2<pg8::EpiSwiGLU2F8, true, true>(lds, HB, D_ / 2, WSB(O_MW), WSB(0), D_ / 2, MW_STRIDE, D_ / 2, S_m, E); }
            GRID_BAR();
        }
    }
    final_norm_rows(SB, out, norm_final, G, bid);
}

#undef IN
#undef x
#undef norm_mix
#undef norm_ffn
#undef norm_final
#undef lru_w_in
#undef lru_b_in
#undef conv_w
#undef conv_b
#undef w_a
#undef b_a
#undef w_i
#undef b_i
#undef lam
#undef lru_w_out
#undef lru_b_out
#undef nsa_w_in
#undef cmp_pe
#undef cmp_w1
#undef cmp_w2
#undef nsa_w_out
#undef ffn_wg
#undef ffn_wu
#undef ffn_wd
#undef w_router
#undef moe_wg
#undef moe_wu
#undef moe_wd
#undef WSB
#undef WLIN
#undef WLOUT
#undef WFGU
#undef WFD
#undef WNIN
#undef WNOUT
#undef WC1K
#undef WC1V
#undef WC2
#undef WMGU
#undef WMD
#undef TAB
#undef HB
#undef BIG
#undef Y
#undef Q
#undef KC
#undef VC
#undef KS
#undef VS
#undef KW
#undef VW
#undef HC
#undef CMP
#undef RG
#undef NGT
#undef BIAS1
#undef out
extern "C" void kernel_launch(void* const* d_in, const int* in_sizes, int n_in, void* d_out, int out_size, void* d_ws, size_t ws_size, hipStream_t stream) {
    static int grid = 0;
    if (grid == 0) {
        if (n_in != 27 || out_size != T_ * D_ || ws_size < WS_NEED) { fprintf(stderr, "kernel_launch: unexpected sizes (n_in %d out %d ws %zu)\n", n_in, out_size, ws_size); grid = -1; return; }
        int dev = 0, cus = 0;
        if (hipGetDevice(&dev) != hipSuccess || hipDeviceGetAttribute(&cus, hipDeviceAttributeMultiprocessorCount, dev) != hipSuccess) { grid = -1; return; }
        if (hipFuncSetAttribute((const void*)mega, hipFuncAttributeMaxDynamicSharedMemorySize, LDS_BYTES) != hipSuccess) { fprintf(stderr, "kernel_launch: hipFuncSetAttribute failed\n"); grid = -1; return; }
        int per_cu = 0;
        if (hipOccupancyMaxActiveBlocksPerMultiprocessor(&per_cu, (const void*)mega, NTHR, LDS_BYTES) != hipSuccess || per_cu < 1) { fprintf(stderr, "kernel_launch: occupancy query says %d\n", per_cu); }
        (void)hipGetLastError();
        grid = cus;
    }
    if (grid < 0) return;
    (void)hipMemsetAsync((unsigned char*)d_ws + O_CTL, 0, CTL_BYTES, stream);
    Params p{};
    for (int i = 0; i < 27; ++i) p.in[i] = (const float*)d_in[i];
    p.out = (float*)d_out; p.ws = (unsigned char*)d_ws;
    hipLaunchKernelGGL(mega, dim3(grid), dim3(NTHR), LDS_BYTES, stream, p);
}
```

```cpp
#include <hip/hip_runtime.h>
#include <cstdio>
#include <cstdint>
namespace pg8 {
#define PG8_LAS __attribute__((address_space(3)))
typedef unsigned short bf16_t;
typedef short bf16x8 __attribute__((ext_vector_type(8)));
typedef float f32x4 __attribute__((ext_vector_type(4)));
typedef unsigned u32x4 __attribute__((ext_vector_type(4)));
constexpr int BM = 256, BK = 64, HALF = 128, HTB = HALF * BK * 2  , STAGE_BYTES = 8 * HTB, NXCD = 8, WGM = 4;

__host__ __device__ __forceinline__ int lds_byte(int r, int c) { const int st = (r >> 4) * 2 + (c >> 5), rr = r & 15, cc = c & 31, ob = rr * 64 + cc * 2; return st * 1024 + (ob ^ (((ob >> 9) & 1) << 5)); }
__host__ __device__ __forceinline__ void stage_rc(int b, int& R, int& C) { const int st = b / 1024, sb = b % 1024, swz = sb ^ (((sb >> 9) & 1) << 5); R = (st >> 1) * 16 + swz / 64; C = (st & 1) * 32 + (swz % 64) / 2; }
__host__ __device__ __forceinline__ int perm32(int rho) { const int n = rho >> 4, i = rho & 15; return 8 * (i >> 2) + 4 * n + (i & 3); }

struct Unit { int pm, pn; };
struct Gemm { const bf16_t* A; const bf16_t* Bt; int M, N, K, lda, ldb, pad; };

struct StaticOrder {
    int nM, nN, nwg, G, c;
    __host__ __device__ void init(int M, int N, int G_, int c_) { nM = M / BM; nN = N / BM; nwg = nM * nN; G = G_; c = c_; }
    __host__ __device__ bool next(int i, Unit& u) const {
        const long L = (long)i * G + c; if (L >= nwg) return false;
        int wgid = (int)L; { const int q = nwg / NXCD, r = nwg % NXCD, xcd = wgid % NXCD, off = wgid / NXCD; wgid = (xcd < r ? xcd * (q + 1) : r * (q + 1) + (xcd - r) * q) + off; }
        const int nig = WGM * nN, gid = wgid / nig, fm = gid * WGM, gsz = (nM - fm) < WGM ? (nM - fm) : WGM;
        u.pm = fm + ((wgid % nig) % gsz); u.pn = (wgid % nig) / gsz; return true;
    }
    __device__ __forceinline__ void a_ready(const Unit&) const {}
    __device__ __forceinline__ void done(const Unit&) const {}
};

__device__ __forceinline__ unsigned cvt_pk_bf16(float lo, float hi) { unsigned r; asm volatile("v_cvt_pk_bf16_f32 %0, %1, %2" : "=v"(r) : "v"(lo), "v"(hi)); return r; }
__device__ __forceinline__ float gelu_tanh(float x) { const float u = 1.5957691216f * (x + 0.044715f * x * x * x); return x * __builtin_amdgcn_rcpf(1.0f + __expf(-u)); }
__device__ __forceinline__ float silu_f(float x) { return x * __builtin_amdgcn_rcpf(1.0f + __expf(-x)); }

struct EpiBf16G {
    static constexpr bool PERM = true, AFTER_DRAIN = false; static constexpr int NST = 0;
    bf16_t* O; const float* bias; const float* rsv; int ldc; int gelu_cols;
    __device__ __forceinline__ void operator()(const f32x4 (&acc)[2][2][4][2], const Unit& u, int wr, int wc, int fr, int fq) const {
        const int row0 = u.pm * BM + wr * 64 + fr, col0 = u.pn * BM + wc * 32 + 8 * fq;
        f32x4 bv[2][2];
#pragma unroll
        for (int bj = 0; bj < 2; ++bj)
#pragma unroll
            for (int n = 0; n < 2; ++n) bv[bj][n] = bias ? *(const f32x4*)(bias + col0 + bj * HALF + 4 * n) : (f32x4){0.f, 0.f, 0.f, 0.f};
        float rr[2][4];
#pragma unroll
        for (int ai = 0; ai < 2; ++ai)
#pragma unroll
            for (int m = 0; m < 4; ++m) rr[ai][m] = rsv ? rsv[row0 + ai * HALF + m * 16] : 1.0f;
        asm volatile("" ::: "memory");
#pragma unroll
        for (int ai = 0; ai < 2; ++ai)
#pragma unroll
            for (int m = 0; m < 4; ++m) { bf16_t* rowp = O + (size_t)(row0 + ai * HALF + m * 16) * ldc + col0; const float r_ = rr[ai][m];
#pragma unroll
                for (int bj = 0; bj < 2; ++bj) { f32x4 v0 = acc[ai][bj][m][0] * r_ + bv[bj][0], v1 = acc[ai][bj][m][1] * r_ + bv[bj][1];
                    if (u.pn * BM + bj * HALF < gelu_cols) {
                        constexpr float c0 = -1.4426950408889634f * 1.5957691216f, c1 = c0 * 0.044715f;
                        f32x4 t0 = v0 * (v0 * v0 * c1 + c0), t1 = v1 * (v1 * v1 * c1 + c0);
#pragma unroll
                        for (int j = 0; j < 4; ++j) { t0[j] = __builtin_amdgcn_exp2f(t0[j]); t1[j] = __builtin_amdgcn_exp2f(t1[j]); }
                        t0 = t0 + 1.0f; t1 = t1 + 1.0f;
#pragma unroll
                        for (int j = 0; j < 4; ++j) { t0[j] = __builtin_amdgcn_rcpf(t0[j]); t1[j] = __builtin_amdgcn_rcpf(t1[j]); }
                        v0 = v0 * t0; v1 = v1 * t1; }
                    u32x4 w; w.x = cvt_pk_bf16(v0[0], v0[1]); w.y = cvt_pk_bf16(v0[2], v0[3]); w.z = cvt_pk_bf16(v1[0], v1[1]); w.w = cvt_pk_bf16(v1[2], v1[3]);
                    *(u32x4*)(rowp + bj * HALF) = w; } }
    }
};
struct EpiResid {
    static constexpr bool PERM = true, AFTER_DRAIN = false;
    const float* R; float* X; const float* bias; const float* rowscale; int ldc; int rs_stride;
    __device__ __forceinline__ void operator()(const f32x4 (&acc)[2][2][4][2], const Unit& u, int wr, int wc, int fr, int fq) const {
        const int row0 = u.pm * BM + wr * 64 + fr, col0 = u.pn * BM + wc * 32 + 8 * fq;
        f32x4 bv[2][2];
#pragma unroll
        for (int bj = 0; bj < 2; ++bj)
#pragma unroll
            for (int n = 0; n < 2; ++n) bv[bj][n] = bias ? *(const f32x4*)(bias + col0 + bj * HALF + 4 * n) : (f32x4){0.f, 0.f, 0.f, 0.f};
#pragma unroll
        for (int ai = 0; ai < 2; ++ai)
#pragma unroll
            for (int m = 0; m < 4; ++m) { const int row = row0 + ai * HALF + m * 16; const size_t off = (size_t)row * ldc + col0;
                const float rs = rowscale ? rowscale[(size_t)row * rs_stride] : 1.0f;
#pragma unroll
                for (int bj = 0; bj < 2; ++bj)
#pragma unroll
                    for (int n = 0; n < 2; ++n) { const f32x4 r = *(const f32x4*)(R + off + bj * HALF + 4 * n);
                        *(f32x4*)(X + off + bj * HALF + 4 * n) = r + (acc[ai][bj][m][n] + bv[bj][n]) * rs; } }
    }
};

__device__ __forceinline__ void unpack8(const u32x4 p, f32x4& lo, f32x4& hi) {
    lo[0] = __uint_as_float(p.x << 16); lo[1] = __uint_as_float(p.x & 0xffff0000u); lo[2] = __uint_as_float(p.y << 16); lo[3] = __uint_as_float(p.y & 0xffff0000u);
    hi[0] = __uint_as_float(p.z << 16); hi[1] = __uint_as_float(p.z & 0xffff0000u); hi[2] = __uint_as_float(p.w << 16); hi[3] = __uint_as_float(p.w & 0xffff0000u); }
__device__ __forceinline__ u32x4 pack8(const f32x4 lo, const f32x4 hi) { u32x4 w; w.x = cvt_pk_bf16(lo[0], lo[1]); w.y = cvt_pk_bf16(lo[2], lo[3]); w.z = cvt_pk_bf16(hi[0], hi[1]); w.w = cvt_pk_bf16(hi[2], hi[3]); return w; }
template <bool R32> struct EpiResidB {
    static constexpr bool PERM = true, AFTER_DRAIN = false; static constexpr int NST = 0;
    const void* R; bf16_t* X; const float* bias; float* rsq; PG8_LAS float* xch; int ldc;
    __device__ __forceinline__ void operator()(const f32x4 (&acc)[2][2][4][2], const Unit& u, int wr, int wc, int fr, int fq) const {
        const int row0 = u.pm * BM + wr * 64 + fr, col0 = u.pn * BM + wc * 32 + 8 * fq;
        f32x4 bv[2][2];
#pragma unroll
        for (int bj = 0; bj < 2; ++bj)
#pragma unroll
            for (int n = 0; n < 2; ++n) bv[bj][n] = bias ? *(const f32x4*)(bias + col0 + bj * HALF + 4 * n) : (f32x4){0.f, 0.f, 0.f, 0.f};
#pragma unroll
        for (int ai = 0; ai < 2; ++ai) { float ssq[2][4] = {{0.f, 0.f, 0.f, 0.f}, {0.f, 0.f, 0.f, 0.f}};
            if constexpr (R32) {
#pragma unroll
                for (int mp = 0; mp < 2; ++mp) { f32x4 rin[2][2][2];
#pragma unroll
                    for (int mm = 0; mm < 2; ++mm)
#pragma unroll
                        for (int bj = 0; bj < 2; ++bj) { const size_t off = (size_t)(row0 + ai * HALF + (2 * mp + mm) * 16) * ldc + col0 + bj * HALF;
                            rin[mm][bj][0] = *(const f32x4*)((const float*)R + off); rin[mm][bj][1] = *(const f32x4*)((const float*)R + off + 4); }
                    asm volatile("" ::: "memory");
#pragma unroll
                    for (int mm = 0; mm < 2; ++mm)
#pragma unroll
                        for (int bj = 0; bj < 2; ++bj) { const int m = 2 * mp + mm; const size_t off = (size_t)(row0 + ai * HALF + m * 16) * ldc + col0 + bj * HALF;
                            const f32x4 n0 = rin[mm][bj][0] + acc[ai][bj][m][0] + bv[bj][0], n1 = rin[mm][bj][1] + acc[ai][bj][m][1] + bv[bj][1];
                            ssq[ai][m] += (n0[0] * n0[0] + n0[1] * n0[1]) + (n0[2] * n0[2] + n0[3] * n0[3]) + (n1[0] * n1[0] + n1[1] * n1[1]) + (n1[2] * n1[2] + n1[3] * n1[3]);
                            *(u32x4*)(X + off) = pack8(n0, n1); } }
            } else { u32x4 rin[4][2];
#pragma unroll
                for (int m = 0; m < 4; ++m)
#pragma unroll
                    for (int bj = 0; bj < 2; ++bj) rin[m][bj] = *(const u32x4*)((const bf16_t*)R + (size_t)(row0 + ai * HALF + m * 16) * ldc + col0 + bj * HALF);
                asm volatile("" ::: "memory");
#pragma unroll
                for (int m = 0; m < 4; ++m)
#pragma unroll
                    for (int bj = 0; bj < 2; ++bj) { f32x4 r0, r1; unpack8(rin[m][bj], r0, r1);
                        const f32x4 n0 = r0 + acc[ai][bj][m][0] + bv[bj][0], n1 = r1 + acc[ai][bj][m][1] + bv[bj][1];
                        ssq[ai][m] += (n0[0] * n0[0] + n0[1] * n0[1]) + (n0[2] * n0[2] + n0[3] * n0[3]) + (n1[0] * n1[0] + n1[1] * n1[1]) + (n1[2] * n1[2] + n1[3] * n1[3]);
                        *(u32x4*)(X + (size_t)(row0 + ai * HALF + m * 16) * ldc + col0 + bj * HALF) = pack8(n0, n1); } }
            if (rsq) {
#pragma unroll
                for (int m = 0; m < 4; ++m) { float t = ssq[ai][m];
                    { const auto r_ = __builtin_amdgcn_permlane16_swap(__float_as_uint(t), __float_as_uint(t), false, false); t = __uint_as_float(r_[0]) + __uint_as_float(r_[1]); }
                    { const auto r_ = __builtin_amdgcn_permlane32_swap(__float_as_uint(t), __float_as_uint(t), false, false); t = __uint_as_float(r_[0]) + __uint_as_float(r_[1]); }
                    if (fq == 0) xch[(wr * 4 + wc) * 128 + (ai * 4 + m) * 16 + fr] = t; }
            }
        }
        if (rsq) {
            asm volatile("s_waitcnt lgkmcnt(0)" ::: "memory"); __builtin_amdgcn_s_barrier(); asm volatile("" ::: "memory");
            if (fq == 0) {
#pragma unroll
                for (int ai = 0; ai < 2; ++ai) { const int o = (ai * 4 + wc) * 16 + fr;
                    const float t = (xch[(wr * 4 + 0) * 128 + o] + xch[(wr * 4 + 1) * 128 + o]) + (xch[(wr * 4 + 2) * 128 + o] + xch[(wr * 4 + 3) * 128 + o]);
                    rsq[(size_t)(row0 + ai * HALF + wc * 16) * 4 + u.pn] = t; }
            }
        }
    }
};

struct EpiNsa {
    static constexpr bool PERM = true, AFTER_DRAIN = false; static constexpr int NST = 0;
    bf16_t *pQ, *pKC, *pVC, *pKS, *pVS, *pKW, *pVW; float* gates; const float* tab; const float* rsq;
    __device__ __forceinline__ void operator()(const f32x4 (&acc)[2][2][4][2], const Unit& u, int wr, int wc, int fr, int fq) const {
        const int row0 = u.pm * BM + wr * 64 + fr, pn = u.pn;
        if (pn == 10) {
#pragma unroll
            for (int ai = 0; ai < 2; ++ai) { float rs[4];
#pragma unroll
                for (int m = 0; m < 4; ++m) { const f32x4 ps = *(const f32x4*)(rsq + (size_t)(row0 + ai * HALF + m * 16) * 4); rs[m] = (ps[0] + ps[1]) + (ps[2] + ps[3]); }
#pragma unroll
                for (int m = 0; m < 4; ++m) rs[m] = __builtin_amdgcn_rsqf(rs[m] * (1.0f / 1024.0f) + 1e-6f);
#pragma unroll
                for (int m = 0; m < 4; ++m) { const int row = row0 + ai * HALF + m * 16;
#pragma unroll
                    for (int n = 0; n < 2; ++n) { const int c = 32 * wc + 8 * fq + 4 * n;
                        if (c < 48) { f32x4 v = acc[ai][0][m][n] * rs[m];
#pragma unroll
                            for (int j = 0; j < 4; ++j) v[j] = __builtin_amdgcn_rcpf(1.0f + __expf(-v[j]));
                            *(f32x4*)(gates + (size_t)row * 48 + c) = v; } } } }
        } else if (pn < 5 || pn == 6 || pn == 8) {
            bf16_t* kb = (pn == 4) ? pKC : (pn == 6 ? pKS : pKW); const float sc = (pn < 4) ? 0.125f : 1.0f;
#pragma unroll
            for (int ai = 0; ai < 2; ++ai) { float rs[4];
#pragma unroll
                for (int m = 0; m < 4; ++m) { const f32x4 ps = *(const f32x4*)(rsq + (size_t)(row0 + ai * HALF + m * 16) * 4); rs[m] = (ps[0] + ps[1]) + (ps[2] + ps[3]); }
#pragma unroll
                for (int m = 0; m < 4; ++m) rs[m] = __builtin_amdgcn_rsqf(rs[m] * (1.0f / 1024.0f) + 1e-6f);
                f32x4 tv[4][4];
#pragma unroll
                for (int m = 0; m < 4; ++m) { const int t = (row0 + ai * HALF + m * 16) & 8191; const f32x4* tp = (const f32x4*)(tab + ((size_t)t * 32 + 8 * fq) * 2);
                    tv[m][0] = tp[0]; tv[m][1] = tp[1]; tv[m][2] = tp[2]; tv[m][3] = tp[3]; }
                asm volatile("" ::: "memory");
#pragma unroll
                for (int m = 0; m < 4; ++m) { const int row = row0 + ai * HALF + m * 16, t = row & 8191, b = row >> 13;
                    const f32x4 t0 = tv[m][0], t1 = tv[m][1], t2 = tv[m][2], t3 = tv[m][3];
                    const float cs[8] = {t0[0], t0[2], t1[0], t1[2], t2[0], t2[2], t3[0], t3[2]}, sn[8] = {t0[1], t0[3], t1[1], t1[3], t2[1], t2[3], t3[1], t3[3]};
                    float o1[8], o2[8];
#pragma unroll
                    for (int n = 0; n < 2; ++n)
#pragma unroll
                        for (int j = 0; j < 4; ++j) { const float x1 = acc[ai][0][m][n][j], x2 = acc[ai][1][m][n][j], c = cs[4 * n + j], s = sn[4 * n + j], scr_ = sc * rs[m];
                            o1[4 * n + j] = (x1 * c - x2 * s) * scr_; o2[4 * n + j] = (x2 * c + x1 * s) * scr_; }
                    bf16_t* dst = (pn < 4) ? pQ + (size_t)row * 1024 + (4 * pn + wc) * 64 + 8 * fq : kb + ((size_t)(b * 4 + wc) * 8192 + t) * 64 + 8 * fq;
                    u32x4 w1, w2; w1.x = cvt_pk_bf16(o1[0], o1[1]); w1.y = cvt_pk_bf16(o1[2], o1[3]); w1.z = cvt_pk_bf16(o1[4], o1[5]); w1.w = cvt_pk_bf16(o1[6], o1[7]);
                    w2.x = cvt_pk_bf16(o2[0], o2[1]); w2.y = cvt_pk_bf16(o2[2], o2[3]); w2.z = cvt_pk_bf16(o2[4], o2[5]); w2.w = cvt_pk_bf16(o2[6], o2[7]);
                    *(u32x4*)dst = w1; *(u32x4*)(dst + 32) = w2; } }
        } else {
            bf16_t* vb = (pn == 5) ? pVC : (pn == 7 ? pVS : pVW);
#pragma unroll
            for (int ai = 0; ai < 2; ++ai) { float rs[4];
#pragma unroll
                for (int m = 0; m < 4; ++m) { const f32x4 ps = *(const f32x4*)(rsq + (size_t)(row0 + ai * HALF + m * 16) * 4); rs[m] = (ps[0] + ps[1]) + (ps[2] + ps[3]); }
#pragma unroll
                for (int m = 0; m < 4; ++m) rs[m] = __builtin_amdgcn_rsqf(rs[m] * (1.0f / 1024.0f) + 1e-6f);
#pragma unroll
                for (int m = 0; m < 4; ++m) { const int row = row0 + ai * HALF + m * 16, t = row & 8191, b = row >> 13;
#pragma unroll
                    for (int bj = 0; bj < 2; ++bj) { const int g = 2 * bj + (wc >> 1), d = 32 * (wc & 1) + 8 * fq; const f32x4 v0 = acc[ai][bj][m][0] * rs[m], v1 = acc[ai][bj][m][1] * rs[m];
                        u32x4 w; w.x = cvt_pk_bf16(v0[0], v0[1]); w.y = cvt_pk_bf16(v0[2], v0[3]); w.z = cvt_pk_bf16(v1[0], v1[1]); w.w = cvt_pk_bf16(v1[2], v1[3]);
                        *(u32x4*)(vb + ((size_t)(b * 4 + g) * 8192 + t) * 64 + d) = w; } } }
        }
    }
};

struct EpiBf16Cols {
    static constexpr bool PERM = true, AFTER_DRAIN = false; static constexpr int NST = 0;
    bf16_t* O; int ldc, clo, chi;
    __device__ __forceinline__ void operator()(const f32x4 (&acc)[2][2][4][2], const Unit& u, int wr, int wc, int fr, int fq) const {
        const int row0 = u.pm * BM + wr * 64 + fr, col0 = u.pn * BM + wc * 32 + 8 * fq;
#pragma unroll
        for (int ai = 0; ai < 2; ++ai)
#pragma unroll
            for (int m = 0; m < 4; ++m) { bf16_t* rowp = O + (size_t)(row0 + ai * HALF + m * 16) * ldc + col0;
#pragma unroll
                for (int bj = 0; bj < 2; ++bj) { const int c = col0 + bj * HALF;
                    if (c >= clo && c < chi) { const f32x4 v0 = acc[ai][bj][m][0], v1 = acc[ai][bj][m][1];
                        u32x4 w; w.x = cvt_pk_bf16(v0[0], v0[1]); w.y = cvt_pk_bf16(v0[2], v0[3]); w.z = cvt_pk_bf16(v1[0], v1[1]); w.w = cvt_pk_bf16(v1[2], v1[3]);
                        *(u32x4*)(rowp + bj * HALF) = w; } } }
    }
};

struct EpiSwiGLU {
    static constexpr bool PERM = true, AFTER_DRAIN = false; static constexpr int NST = 0;
    bf16_t* H; const float* rsq; int ldc; int pad;
    __device__ __forceinline__ void operator()(const f32x4 (&acc)[2][2][4][2], const Unit& u, int wr, int wc, int fr, int fq) const {
        const int row0 = u.pm * BM + wr * 64 + fr, col0 = u.pn * HALF + wc * 32 + 8 * fq;
#pragma unroll
        for (int ai = 0; ai < 2; ++ai) { float rs[4];
#pragma unroll
            for (int m = 0; m < 4; ++m) { const f32x4 ps = *(const f32x4*)(rsq + (size_t)(row0 + ai * HALF + m * 16) * 4); rs[m] = (ps[0] + ps[1]) + (ps[2] + ps[3]); }
#pragma unroll
            for (int m = 0; m < 4; ++m) rs[m] = rs[m] * (1.0f / 1024.0f) + 1e-6f;
#pragma unroll
            for (int m = 0; m < 4; ++m) { bf16_t* rowp = H + (size_t)(row0 + ai * HALF + m * 16) * ldc + col0; const float q = rs[m], c1 = -1.4426950408889634f * __builtin_amdgcn_rsqf(q);
                f32x4 vv[2];
#pragma unroll
                for (int n = 0; n < 2; ++n) { const f32x4 g = acc[ai][0][m][n], uu = acc[ai][1][m][n]; f32x4 e = g * c1;
                    e[0] = __builtin_amdgcn_exp2f(e[0]); e[1] = __builtin_amdgcn_exp2f(e[1]); e[2] = __builtin_amdgcn_exp2f(e[2]); e[3] = __builtin_amdgcn_exp2f(e[3]);
                    f32x4 d = e * q + q;
                    d[0] = __builtin_amdgcn_rcpf(d[0]); d[1] = __builtin_amdgcn_rcpf(d[1]); d[2] = __builtin_amdgcn_rcpf(d[2]); d[3] = __builtin_amdgcn_rcpf(d[3]);
                    vv[n] = (g * uu) * d; }
                u32x4 w; w.x = cvt_pk_bf16(vv[0][0], vv[0][1]); w.y = cvt_pk_bf16(vv[0][2], vv[0][3]); w.z = cvt_pk_bf16(vv[1][0], vv[1][1]); w.w = cvt_pk_bf16(vv[1][2], vv[1][3]);
                *(u32x4*)rowp = w; } }
    }
};

template <class Epi, class Sched, bool ALIGN_EPI = false, bool SP2 = false>
__device__ __forceinline__ void gemm_phase(PG8_LAS unsigned char* lds, const Gemm g, const Sched& S, const Epi& E) {
    int tid_raw = threadIdx.x; asm volatile("" : "+v"(tid_raw));
    const int tid = tid_raw, wid = __builtin_amdgcn_readfirstlane(tid >> 6), lane = tid & 63, wr = wid >> 2, wc = wid & 3, fr = lane & 15, fq = lane >> 4;
    const int K = g.K, nt = K / BK;
    unsigned voffA[2], voffB[2];
#pragma unroll
    for (int i = 0; i < 2; ++i) { int R, C; stage_rc(tid * 16 + i * 8192, R, C); const int Rb = Epi::PERM ? ((R & ~31) + perm32(R & 31)) : R;
        voffA[i] = (unsigned)(R * g.lda + C) * 2u; voffB[i] = (unsigned)(Rb * g.ldb + C) * 2u; }
    const size_t kstep = (size_t)(BK * 2);
    const size_t hstepA = (size_t)HALF * g.lda * 2, hstepB = (size_t)HALF * g.ldb * 2;
    const size_t tstepA = 2 * hstepA, tstepB = 2 * hstepB;
    const unsigned ldsw = (unsigned)wid * 1024u;
    const int aoff = lds_byte(wr * 64 + fr, fq * 8), boff = lds_byte(wc * 32 + fr, fq * 8);
#define PG8_SA(b, h) (((b) * 2 + (h)) * HTB)
#define PG8_SB(b, h) ((4 + (b) * 2 + (h)) * HTB)
#define PG8_STAGE(bufoff, gbase, voff) do { _Pragma("unroll") for (int _i = 0; _i < 2; ++_i) \
        __builtin_amdgcn_global_load_lds((const unsigned*)((const char*)(gbase) + (voff)[_i]), (PG8_LAS unsigned*)(lds + (bufoff) + ldsw + _i * 8192), 16, 0, 0); } while (0)
#define PG8_LDA(dst, b, h) do { _Pragma("unroll") for (int m = 0; m < 4; ++m) _Pragma("unroll") for (int k = 0; k < 2; ++k) dst[m][k] = *(const PG8_LAS bf16x8*)(lds + PG8_SA(b, h) + aoff + m * 2048 + k * 1024); } while (0)
#define PG8_LDB(dst, b, h) do { _Pragma("unroll") for (int n = 0; n < 2; ++n) _Pragma("unroll") for (int k = 0; k < 2; ++k) dst[n][k] = *(const PG8_LAS bf16x8*)(lds + PG8_SB(b, h) + boff + n * 2048 + k * 1024); } while (0)
#define PG8_MMA(ai, bj, At, Bt) do { __builtin_amdgcn_s_setprio(1); _Pragma("unroll") for (int m = 0; m < 4; ++m) _Pragma("unroll") for (int n = 0; n < 2; ++n) _Pragma("unroll") for (int k = 0; k < 2; ++k) \
        acc[ai][bj][m][n] = __builtin_amdgcn_mfma_f32_16x16x32_bf16(Bt[n][k], At[m][k], acc[ai][bj][m][n], 0, 0, 0); __builtin_amdgcn_s_setprio(0); } while (0)
#define PG8_WAIT_V(n) asm volatile("s_waitcnt vmcnt(" #n ")" ::: "memory")
#define PG8_WAIT_VF(first_) do { if (first_) asm volatile("s_waitcnt vmcnt(%0)" :: "n"(8 + Epi::NST) : "memory"); else asm volatile("s_waitcnt vmcnt(8)" ::: "memory"); } while (0)
#define PG8_WAIT_L(n) asm volatile("s_waitcnt lgkmcnt(" #n ")" ::: "memory")
#define PG8_BAR __builtin_amdgcn_s_barrier()
#define PG8_SCHED __builtin_amdgcn_sched_barrier(0)
    Unit cur, nxt; int ui = 0;
    if (!S.next(0, cur)) return;
    f32x4 acc[2][2][4][2];
#pragma unroll
    for (int a = 0; a < 2; ++a)
#pragma unroll
        for (int b = 0; b < 2; ++b)
#pragma unroll
            for (int m = 0; m < 4; ++m)
#pragma unroll
                for (int n = 0; n < 2; ++n) acc[a][b][m][n] = (f32x4){0.f, 0.f, 0.f, 0.f};
    bf16x8 At[4][2], B0[2][2], B1[2][2];
    const char* cA = (const char*)g.A + (size_t)cur.pm * tstepA; const char* cB = (const char*)g.Bt + (size_t)cur.pn * tstepB;
    S.a_ready(cur);
    if constexpr (SP2) {
        PG8_STAGE(PG8_SB(0, 0), cB, voffB); PG8_STAGE(PG8_SB(0, 1), cB + hstepB, voffB); PG8_STAGE(PG8_SA(0, 0), cA, voffA); PG8_STAGE(PG8_SA(0, 1), cA + hstepA, voffA);
        if (wr == 1) PG8_BAR;
        PG8_WAIT_V(2); PG8_BAR;
        PG8_STAGE(PG8_SB(1, 0), cB + kstep, voffB); PG8_STAGE(PG8_SA(1, 0), cA + kstep, voffA); PG8_STAGE(PG8_SB(1, 1), cB + hstepB + kstep, voffB);
        PG8_WAIT_V(6); PG8_BAR;
    } else {
        PG8_STAGE(PG8_SB(0, 0), cB, voffB); PG8_STAGE(PG8_SA(0, 0), cA, voffA); PG8_STAGE(PG8_SB(0, 1), cB + hstepB, voffB); PG8_STAGE(PG8_SA(0, 1), cA + hstepA, voffA);
        if (wr == 1) PG8_BAR;
        PG8_WAIT_V(4); PG8_BAR;
        PG8_STAGE(PG8_SB(1, 0), cB + kstep, voffB); PG8_STAGE(PG8_SA(1, 0), cA + kstep, voffA); PG8_STAGE(PG8_SB(1, 1), cB + hstepB + kstep, voffB);
        PG8_WAIT_V(6); PG8_BAR;
    }
    for (;;) {
        const bool has_next = S.next(ui + 1, nxt);
        const char* nA = has_next ? (const char*)g.A + (size_t)nxt.pm * tstepA : cA; const char* nB = has_next ? (const char*)g.Bt + (size_t)nxt.pn * tstepB : cB;
        for (int t = 0; t < nt; t += 2) {
            const bool last = (t == nt - 2);
            const char* a1 = cA + (size_t)(t + 1) * kstep;
            const char* a2 = last ? nA : cA + (size_t)(t + 2) * kstep; const char* b2 = last ? nB : cB + (size_t)(t + 2) * kstep;
            const char* a3 = a2 + kstep; const char* b3 = b2 + kstep;
            if (last && has_next) S.a_ready(nxt);
            if constexpr (SP2) {
            const bool firstk = (t == 0) && (ui > 0) && (Epi::NST > 0);
            PG8_LDB(B0, 0, 0); PG8_LDB(B1, 0, 1); PG8_SCHED; PG8_LDA(At, 0, 0); PG8_STAGE(PG8_SA(1, 1), a1 + hstepA, voffA);
            PG8_WAIT_VF(firstk); PG8_WAIT_L(0); PG8_BAR; PG8_MMA(0, 0, At, B0); PG8_MMA(0, 1, At, B1); PG8_BAR; PG8_SCHED;
            PG8_LDA(At, 0, 1); PG8_STAGE(PG8_SB(0, 0), b2, voffB); PG8_STAGE(PG8_SB(0, 1), b2 + hstepB, voffB); PG8_STAGE(PG8_SA(0, 0), a2, voffA);
            PG8_WAIT_VF(firstk); PG8_WAIT_L(0); PG8_BAR; PG8_MMA(1, 0, At, B0); PG8_MMA(1, 1, At, B1); PG8_BAR; PG8_SCHED;
            PG8_LDB(B0, 1, 0); PG8_LDB(B1, 1, 1); PG8_SCHED; PG8_LDA(At, 1, 0); PG8_STAGE(PG8_SA(0, 1), a2 + hstepA, voffA);
            PG8_WAIT_V(8); PG8_WAIT_L(0); PG8_BAR; PG8_MMA(0, 0, At, B0); PG8_MMA(0, 1, At, B1); PG8_BAR; PG8_SCHED;
            PG8_LDA(At, 1, 1); PG8_STAGE(PG8_SB(1, 0), b3, voffB); PG8_STAGE(PG8_SB(1, 1), b3 + hstepB, voffB); PG8_STAGE(PG8_SA(1, 0), a3, voffA);
            PG8_WAIT_V(8); PG8_WAIT_L(0); PG8_BAR; PG8_MMA(1, 0, At, B0); PG8_MMA(1, 1, At, B1); PG8_BAR; PG8_SCHED;
            } else {
            PG8_LDB(B0, 0, 0); PG8_SCHED; PG8_LDA(At, 0, 0); PG8_STAGE(PG8_SA(1, 1), a1 + hstepA, voffA);
            PG8_WAIT_L(8); PG8_BAR; PG8_WAIT_L(0); PG8_MMA(0, 0, At, B0); PG8_BAR; PG8_SCHED;
            PG8_LDB(B1, 0, 1); PG8_STAGE(PG8_SB(0, 0), b2, voffB);
            PG8_BAR; PG8_WAIT_L(0); PG8_MMA(0, 1, At, B1); PG8_BAR;
            PG8_LDA(At, 0, 1); PG8_STAGE(PG8_SA(0, 0), a2, voffA);
            PG8_BAR; PG8_WAIT_L(0); PG8_MMA(1, 0, At, B0); PG8_BAR; PG8_SCHED;
            PG8_STAGE(PG8_SB(0, 1), b2 + hstepB, voffB);
            PG8_WAIT_V(6); PG8_BAR; PG8_MMA(1, 1, At, B1); PG8_BAR;
            PG8_LDB(B0, 1, 0); PG8_SCHED; PG8_LDA(At, 1, 0); PG8_STAGE(PG8_SA(0, 1), a2 + hstepA, voffA);
            PG8_WAIT_L(8); PG8_BAR; PG8_WAIT_L(0); PG8_MMA(0, 0, At, B0); PG8_BAR; PG8_SCHED;
            PG8_LDB(B1, 1, 1); PG8_STAGE(PG8_SB(1, 0), b3, voffB);
            PG8_BAR; PG8_WAIT_L(0); PG8_MMA(0, 1, At, B1); PG8_BAR;
            PG8_LDA(At, 1, 1); PG8_STAGE(PG8_SA(1, 0), a3, voffA);
            PG8_BAR; PG8_WAIT_L(0); PG8_MMA(1, 0, At, B0); PG8_BAR; PG8_SCHED;
            PG8_STAGE(PG8_SB(1, 1), b3 + hstepB, voffB);
            PG8_WAIT_V(6); PG8_BAR; PG8_MMA(1, 1, At, B1); PG8_BAR;
            }
        }
        if constexpr (ALIGN_EPI) { if (wr == 0) PG8_BAR; }
        if constexpr (!Epi::AFTER_DRAIN) { E(acc, cur, wr, wc, fr, fq); S.done(cur); }
        if (!has_next) break;
#pragma unroll
        for (int a = 0; a < 2; ++a)
#pragma unroll
            for (int b = 0; b < 2; ++b)
#pragma unroll
                for (int m = 0; m < 4; ++m)
#pragma unroll
                    for (int n = 0; n < 2; ++n) acc[a][b][m][n] = (f32x4){0.f, 0.f, 0.f, 0.f};
        cur = nxt; cA = nA; cB = nB; ++ui;
        if constexpr (ALIGN_EPI) { if (wr == 1) PG8_BAR; }
    }
    PG8_WAIT_V(0);
    if constexpr (!ALIGN_EPI) { if (wr == 0) PG8_BAR; }
    PG8_BAR;
    if constexpr (Epi::AFTER_DRAIN) { E.fused(acc, cur, wr, wc, fr, fq, lds, wid, lane); S.done(cur); }
#undef PG8_SA
#undef PG8_SB
#undef PG8_STAGE
#undef PG8_LDA
#undef PG8_LDB
#undef PG8_MMA
#undef PG8_WAIT_V
#undef PG8_WAIT_VF
#undef PG8_WAIT_L
#undef PG8_BAR
#undef PG8_SCHED
}

typedef int v8i_t __attribute__((ext_vector_type(8)));
typedef int v4i_t __attribute__((ext_vector_type(4)));
__device__ __forceinline__ v8i_t cat8(const bf16x8& lo, const bf16x8& hi) { const v4i_t a = __builtin_bit_cast(v4i_t, lo), b = __builtin_bit_cast(v4i_t, hi); return (v8i_t){a[0], a[1], a[2], a[3], b[0], b[1], b[2], b[3]}; }
__device__ __forceinline__ float cl8(float x) { return fminf(fmaxf(x, -448.0f), 448.0f); }
__device__ __forceinline__ unsigned pk_fp8x4(float a, float b, float c, float d) { int w = __builtin_amdgcn_cvt_pk_fp8_f32(cl8(a), cl8(b), 0, false); w = __builtin_amdgcn_cvt_pk_fp8_f32(cl8(c), cl8(d), w, true); return (unsigned)w; }
__device__ __forceinline__ unsigned pk_fp8x4m(float a, float b, float c, float d) { int w = __builtin_amdgcn_cvt_pk_fp8_f32(__builtin_amdgcn_fmed3f(a, -448.0f, 448.0f), __builtin_amdgcn_fmed3f(b, -448.0f, 448.0f), 0, false);
    w = __builtin_amdgcn_cvt_pk_fp8_f32(__builtin_amdgcn_fmed3f(c, -448.0f, 448.0f), __builtin_amdgcn_fmed3f(d, -448.0f, 448.0f), w, true); return (unsigned)w; }
struct Unit2 { int pm, pn, l, j, nv, e; };
struct MoeSched {
    const int* idx; const PG8_LAS unsigned* tt; int cap, pass, nN, t0, ntile, jb, je, step;
    __device__ __forceinline__ void init(const PG8_LAS unsigned* tt_, const int* idx_, int cap_, int pass_, int nN_, int t0_, int ntile_, int jb_, int je_, int step_) {
        idx = idx_; tt = tt_; cap = cap_; pass = pass_; nN = nN_; t0 = t0_; ntile = ntile_; jb = jb_; je = je_; step = step_; }
    __device__ __forceinline__ bool next(int i, Unit2& u) const {
        const int L = jb + i * step; if (L >= je) return false;
        u.pm = L % ntile; u.pn = L / ntile; const unsigned w = (unsigned)__builtin_amdgcn_readfirstlane((int)tt[t0 + u.pm]);
        u.e = (int)(w >> 20); u.l = pass * 8 + u.e; u.j = (int)((w >> 10) & 1023u); u.nv = (int)(w & 1023u); return true;
    }
    __device__ __forceinline__ const int* rowp(const Unit2& u, int r) const { const int rc = r < u.nv ? r : u.nv - 1; return idx + (size_t)u.l * cap + 256 * u.j + rc; }
    __device__ __forceinline__ int row(const Unit2& u, int r) const { const int rc = r < u.nv ? r : u.nv - 1; return idx[(size_t)u.l * cap + 256 * u.j + rc]; }
};
__device__ __forceinline__ void moe_build_table(PG8_LAS unsigned* tt, const int* cnt, int pass) {
    if (threadIdx.x == 0) { int n = 0;
        for (int e = 0; e < 8; ++e) { const int ce = cnt[pass * 8 + e]; for (int j = 0; 256 * j < ce; ++j) { const int rem = ce - 256 * j; tt[n++] = ((unsigned)e << 20) | ((unsigned)j << 10) | (unsigned)(rem < 256 ? rem : 256); } }
        tt[255] = (unsigned)n; }
}
template <class Epi, bool GATHER, bool F8 = false>
__device__ __forceinline__ void gemm_phase2(PG8_LAS unsigned char* lds, const bf16_t* A, int lda, const bf16_t* Bt, const bf16_t* Bt7, int ldb, size_t bexp, int K, const MoeSched& S, const Epi& E) {
    int tid_raw = threadIdx.x; asm volatile("" : "+v"(tid_raw));
    const int tid = tid_raw, wid = __builtin_amdgcn_readfirstlane(tid >> 6), lane = tid & 63, wr = wid >> 2, wc = wid & 3, fr = lane & 15, fq = lane >> 4;
    const int nt = K / BK;
    int Rst[2], Cst[2]; unsigned voffB[2];
#pragma unroll
    for (int i = 0; i < 2; ++i) { int R, C; stage_rc(tid * 16 + i * 8192, R, C); const int Rb = Epi::PERM ? ((R & ~31) + perm32(R & 31)) : R; Rst[i] = R; Cst[i] = C; voffB[i] = (unsigned)(Rb * ldb + C) * 2u; }
    const size_t kstep = (size_t)(BK * 2);
    const size_t hstepB = (size_t)HALF * ldb * 2, tstepB = 2 * hstepB, tstepA = (size_t)BM * lda * 2;
    const unsigned ldsw = (unsigned)wid * 1024u;
    const int aoff = lds_byte(wr * 64 + fr, fq * 8), boff = lds_byte(wc * 32 + fr, fq * 8);
#define PG8_SA(b, h) (((b) * 2 + (h)) * HTB)
#define PG8_SB(b, h) ((4 + (b) * 2 + (h)) * HTB)
#define PG8_STAGE(bufoff, gbase, voff) do { _Pragma("unroll") for (int _i = 0; _i < 2; ++_i) \
        __builtin_amdgcn_global_load_lds((const unsigned*)((const char*)(gbase) + (voff)[_i]), (PG8_LAS unsigned*)(lds + (bufoff) + ldsw + _i * 8192), 16, 0, 0); } while (0)
#define PG8_LD8(dst_, base_) do { const v4i_t lo_ = *(const PG8_LAS v4i_t*)(base_), hi_ = *(const PG8_LAS v4i_t*)((base_) + 1024); dst_ = __builtin_shufflevector(lo_, hi_, 0, 1, 2, 3, 4, 5, 6, 7); } while (0)
#define PG8_LDA(dst, b, h) do { _Pragma("unroll") for (int m = 0; m < 4; ++m) { if constexpr (F8) PG8_LD8(dst##8[m], lds + PG8_SA(b, h) + aoff + m * 2048); \
        else { _Pragma("unroll") for (int k = 0; k < 2; ++k) dst[m][k] = *(const PG8_LAS bf16x8*)(lds + PG8_SA(b, h) + aoff + m * 2048 + k * 1024); } } } while (0)
#define PG8_LDB(dst, b, h) do { _Pragma("unroll") for (int n = 0; n < 2; ++n) { if constexpr (F8) PG8_LD8(dst##8[n], lds + PG8_SB(b, h) + boff + n * 2048); \
        else { _Pragma("unroll") for (int k = 0; k < 2; ++k) dst[n][k] = *(const PG8_LAS bf16x8*)(lds + PG8_SB(b, h) + boff + n * 2048 + k * 1024); } } } while (0)
#define PG8_MMA(ai, bj, At, Bt) do { __builtin_amdgcn_s_setprio(1); _Pragma("unroll") for (int m = 0; m < 4; ++m) _Pragma("unroll") for (int n = 0; n < 2; ++n) { \
        if constexpr (F8) { asm volatile("v_mfma_scale_f32_16x16x128_f8f6f4 %0, %1, %2, %0, %3, %3 op_sel_hi:[0,0,0]" : "+v"(acc[ai][bj][m][n]) : "v"(Bt##8[n]), "v"(At##8[m]), "v"(scl8)); } \
        else { _Pragma("unroll") for (int k = 0; k < 2; ++k) acc[ai][bj][m][n] = __builtin_amdgcn_mfma_f32_16x16x32_bf16(Bt[n][k], At[m][k], acc[ai][bj][m][n], 0, 0, 0); } } \
        __builtin_amdgcn_s_setprio(0); } while (0)
#define PG8_WAIT_V(n) asm volatile("s_waitcnt vmcnt(" #n ")" ::: "memory")
#define PG8_WAIT_VF(first_) do { if (first_) asm volatile("s_waitcnt vmcnt(%0)" :: "n"(8 + Epi::NST) : "memory"); else asm volatile("s_waitcnt vmcnt(8)" ::: "memory"); } while (0)
#define PG8_WAIT_L(n) asm volatile("s_waitcnt lgkmcnt(" #n ")" ::: "memory")
#define PG8_BAR __builtin_amdgcn_s_barrier()
#define PG8_SCHED __builtin_amdgcn_sched_barrier(0)
#define PG8_AOFFS(dst, u) do { _Pragma("unroll") for (int _h = 0; _h < 2; ++_h) _Pragma("unroll") for (int _i = 0; _i < 2; ++_i) { const int _r = _h * HALF + Rst[_i]; \
        const int _row = GATHER ? S.row((u), _r) : _r; dst[_h][_i] = (unsigned)(_row * lda + Cst[_i]) * 2u; } } while (0)
    Unit2 cur, nxt; int ui = 0;
    if (!S.next(0, cur)) return;
    f32x4 acc[2][2][4][2];
#pragma unroll
    for (int a = 0; a < 2; ++a)
#pragma unroll
        for (int b = 0; b < 2; ++b)
#pragma unroll
            for (int m = 0; m < 4; ++m)
#pragma unroll
                for (int n = 0; n < 2; ++n) acc[a][b][m][n] = (f32x4){0.f, 0.f, 0.f, 0.f};
    bf16x8 At[4][2], B0[2][2], B1[2][2]; v8i_t At8[4], B08[2], B18[2];
    int scl8 = 0x7f7f7f7f; asm volatile("" : "+v"(scl8));
    unsigned cvo[2][2], nvo[2][2];
    PG8_AOFFS(cvo, cur);
    const char* cA = GATHER ? (const char*)A : (const char*)A + (size_t)cur.pm * tstepA;
    const char* cB = (cur.e == 7 ? (const char*)Bt7 : (const char*)Bt + (size_t)cur.e * bexp) + (size_t)cur.pn * tstepB;
    PG8_STAGE(PG8_SB(0, 0), cB, voffB); PG8_STAGE(PG8_SB(0, 1), cB + hstepB, voffB); PG8_STAGE(PG8_SA(0, 0), cA, cvo[0]); PG8_STAGE(PG8_SA(0, 1), cA, cvo[1]);
    if (wr == 1) PG8_BAR;
    PG8_WAIT_V(2); PG8_BAR;
    PG8_STAGE(PG8_SB(1, 0), cB + kstep, voffB); PG8_STAGE(PG8_SA(1, 0), cA + kstep, cvo[0]); PG8_STAGE(PG8_SB(1, 1), cB + hstepB + kstep, voffB);
    PG8_WAIT_V(6); PG8_BAR;
    Unit2 nn; bool has_next = S.next(1, nxt), has_nn = false;
    if (has_next) { PG8_AOFFS(nvo, nxt); }
    else {
#pragma unroll
        for (int h = 0; h < 2; ++h)
#pragma unroll
            for (int i = 0; i < 2; ++i) nvo[h][i] = cvo[h][i];
    }
    for (;;) {
        const char* nA = cA; const char* nB = cB;
        if (has_next) { nA = GATHER ? (const char*)A : (const char*)A + (size_t)nxt.pm * tstepA; nB = (nxt.e == 7 ? (const char*)Bt7 : (const char*)Bt + (size_t)nxt.e * bexp) + (size_t)nxt.pn * tstepB; }
        for (int t = 0; t < nt; t += 2) {
            const bool last = (t == nt - 2);
            const char* a1 = cA + (size_t)(t + 1) * kstep;
            const char* a2 = last ? nA : cA + (size_t)(t + 2) * kstep; const char* b2 = last ? nB : cB + (size_t)(t + 2) * kstep;
            const char* a3 = a2 + kstep; const char* b3 = b2 + kstep;
            unsigned v2[2][2];
#pragma unroll
            for (int h = 0; h < 2; ++h)
#pragma unroll
                for (int i = 0; i < 2; ++i) v2[h][i] = last ? nvo[h][i] : cvo[h][i];
            const bool firstk = (t == 0) && (ui > 0) && (Epi::NST > 0);
            PG8_LDB(B0, 0, 0); PG8_LDB(B1, 0, 1); PG8_SCHED; PG8_LDA(At, 0, 0); PG8_STAGE(PG8_SA(1, 1), a1, cvo[1]);
            PG8_WAIT_VF(firstk); PG8_WAIT_L(0); PG8_BAR; PG8_MMA(0, 0, At, B0); PG8_MMA(0, 1, At, B1); PG8_BAR; PG8_SCHED;
            PG8_LDA(At, 0, 1); PG8_STAGE(PG8_SB(0, 0), b2, voffB); PG8_STAGE(PG8_SB(0, 1), b2 + hstepB, voffB); PG8_STAGE(PG8_SA(0, 0), a2, v2[0]);
            PG8_WAIT_VF(firstk); PG8_WAIT_L(0); PG8_BAR; PG8_MMA(1, 0, At, B0); PG8_MMA(1, 1, At, B1); PG8_BAR; PG8_SCHED;
            PG8_LDB(B0, 1, 0); PG8_LDB(B1, 1, 1); PG8_SCHED; PG8_LDA(At, 1, 0); PG8_STAGE(PG8_SA(0, 1), a2, v2[1]);
            PG8_WAIT_V(8); PG8_WAIT_L(0); PG8_BAR; PG8_MMA(0, 0, At, B0); PG8_MMA(0, 1, At, B1); PG8_BAR; PG8_SCHED;
            PG8_LDA(At, 1, 1); PG8_STAGE(PG8_SB(1, 0), b3, voffB); PG8_STAGE(PG8_SB(1, 1), b3 + hstepB, voffB); PG8_STAGE(PG8_SA(1, 0), a3, v2[0]);
            PG8_WAIT_V(8); PG8_WAIT_L(0); PG8_BAR; PG8_MMA(1, 0, At, B0); PG8_MMA(1, 1, At, B1); PG8_BAR; PG8_SCHED;
        }
        int nr[2][2];
        has_nn = has_next && S.next(ui + 2, nn);
        if (!has_nn) nn = cur;
        if constexpr (GATHER) {
#pragma unroll
            for (int h = 0; h < 2; ++h)
#pragma unroll
                for (int i = 0; i < 2; ++i) { const int* ip = S.rowp(nn, h * HALF + Rst[i]); asm volatile("global_load_dword %0, %1, off" : "=&v"(nr[h][i]) : "v"(ip) : "memory"); }
        }
        if (wr == 0) PG8_BAR;
        if constexpr (F8) asm volatile("s_nop 7\n\ts_nop 7\n\ts_nop 7\n\ts_nop 7" ::: "memory");
        E(acc, cur, wr, wc, fr, fq);
        if constexpr (GATHER) asm volatile("s_waitcnt vmcnt(%4)" : "+v"(nr[0][0]), "+v"(nr[0][1]), "+v"(nr[1][0]), "+v"(nr[1][1]) : "n"(Epi::NST) : "memory");
        if (!has_next) break;
#pragma unroll
        for (int a = 0; a < 2; ++a)
#pragma unroll
            for (int b = 0; b < 2; ++b)
#pragma unroll
                for (int m = 0; m < 4; ++m)
#pragma unroll
                    for (int n = 0; n < 2; ++n) acc[a][b][m][n] = (f32x4){0.f, 0.f, 0.f, 0.f};
        cur = nxt; cA = nA; cB = nB; ++ui;
#pragma unroll
        for (int h = 0; h < 2; ++h)
#pragma unroll
            for (int i = 0; i < 2; ++i) cvo[h][i] = nvo[h][i];
        nxt = nn; has_next = has_nn;
        if (has_next) {
#pragma unroll
            for (int h = 0; h < 2; ++h)
#pragma unroll
                for (int i = 0; i < 2; ++i) { const int row_ = GATHER ? nr[h][i] : h * HALF + Rst[i]; nvo[h][i] = (unsigned)(row_ * lda + Cst[i]) * 2u; }
        }
        if (wr == 1) PG8_BAR;
    }
    PG8_WAIT_V(0);
    PG8_BAR;
#undef PG8_AOFFS
#undef PG8_SA
#undef PG8_SB
#undef PG8_STAGE
#undef PG8_LDA
#undef PG8_LD8
#undef PG8_LDB
#undef PG8_MMA
#undef PG8_WAIT_V
#undef PG8_WAIT_VF
#undef PG8_WAIT_L
#undef PG8_BAR
#undef PG8_SCHED
}
struct EpiSwiGLU2 {
    static constexpr bool PERM = true, AFTER_DRAIN = false; static constexpr int NST = 0;
    bf16_t* H; int ldc; int pad;
    __device__ __forceinline__ void operator()(const f32x4 (&acc)[2][2][4][2], const Unit2& u, int wr, int wc, int fr, int fq) const {
        const int row0 = u.pm * BM + wr * 64 + fr, col0 = u.pn * HALF + wc * 32 + 8 * fq;
#pragma unroll
        for (int ai = 0; ai < 2; ++ai)
#pragma unroll
            for (int m = 0; m < 4; ++m) { bf16_t* rowp = H + (size_t)(row0 + ai * HALF + m * 16) * ldc + col0;
                f32x4 v0, v1;
#pragma unroll
                for (int j = 0; j < 4; ++j) { v0[j] = silu_f(acc[ai][0][m][0][j]) * acc[ai][1][m][0][j]; v1[j] = silu_f(acc[ai][0][m][1][j]) * acc[ai][1][m][1][j]; }
                u32x4 w; w.x = cvt_pk_bf16(v0[0], v0[1]); w.y = cvt_pk_bf16(v0[2], v0[3]); w.z = cvt_pk_bf16(v1[0], v1[1]); w.w = cvt_pk_bf16(v1[2], v1[3]);
                *(u32x4*)rowp = w; }
    }
};
struct EpiSwiGLU2F8 {
    static constexpr bool PERM = true, AFTER_DRAIN = false; static constexpr int NST = 8;
    unsigned char* H; int ldc; float inv, oscale; int pad;
    __device__ __forceinline__ void operator()(const f32x4 (&acc)[2][2][4][2], const Unit2& u, int wr, int wc, int fr, int fq) const {
        const int row0 = u.pm * BM + wr * 64 + fr, col0 = u.pn * HALF + wc * 32 + 8 * fq;
        const float ne = -1.4426950408889634f * inv, kinv = 1.0f / (inv * inv * oscale);
#pragma unroll
        for (int ai = 0; ai < 2; ++ai)
#pragma unroll
            for (int m = 0; m < 4; ++m) { unsigned char* rowp = H + (size_t)(row0 + ai * HALF + m * 16) * ldc + col0;
                f32x4 vv[2];
#pragma unroll
                for (int n = 0; n < 2; ++n) { const f32x4 g = acc[ai][0][m][n], uu = acc[ai][1][m][n]; f32x4 e = g * ne;
                    e[0] = __builtin_amdgcn_exp2f(e[0]); e[1] = __builtin_amdgcn_exp2f(e[1]); e[2] = __builtin_amdgcn_exp2f(e[2]); e[3] = __builtin_amdgcn_exp2f(e[3]);
                    f32x4 d = e * kinv + kinv;
                    d[0] = __builtin_amdgcn_rcpf(d[0]); d[1] = __builtin_amdgcn_rcpf(d[1]); d[2] = __builtin_amdgcn_rcpf(d[2]); d[3] = __builtin_amdgcn_rcpf(d[3]);
                    vv[n] = (g * uu) * d; }
                uint2 w; w.x = pk_fp8x4m(vv[0][0], vv[0][1], vv[0][2], vv[0][3]); w.y = pk_fp8x4m(vv[1][0], vv[1][1], vv[1][2], vv[1][3]);
                *(uint2*)rowp = w; }
    }
};
struct EpiMoeDown {
    static constexpr bool PERM = true, AFTER_DRAIN = false; static constexpr int NST = 0;
    bf16_t* X; const int* idx; const float* wrow; int ldc; int cap; float inv; int pad;
    __device__ __forceinline__ void operator()(const f32x4 (&acc)[2][2][4][2], const Unit2& u, int wr, int wc, int fr, int fq) const {
        const int r0 = wr * 64 + fr, col0 = u.pn * BM + wc * 32 + 8 * fq;
#pragma unroll
        for (int ai = 0; ai < 2; ++ai) { int tok[4]; float wv[4]; u32x4 xin[4][2];
#pragma unroll
            for (int m = 0; m < 4; ++m) { const int r = r0 + ai * HALF + m * 16, rc = r < u.nv ? r : u.nv - 1; const size_t li = (size_t)u.l * cap + 256 * u.j + rc; tok[m] = idx[li]; wv[m] = wrow[li] * inv; }
#pragma unroll
            for (int m = 0; m < 4; ++m)
#pragma unroll
                for (int bj = 0; bj < 2; ++bj) xin[m][bj] = *(const u32x4*)(X + (size_t)tok[m] * ldc + col0 + bj * HALF);
#pragma unroll
            for (int m = 0; m < 4; ++m) { const int r = r0 + ai * HALF + m * 16;
                if (r < u.nv) { bf16_t* xp = X + (size_t)tok[m] * ldc + col0;
#pragma unroll
                    for (int bj = 0; bj < 2; ++bj) { f32x4 r0v, r1v; unpack8(xin[m][bj], r0v, r1v); *(u32x4*)(xp + bj * HALF) = pack8(r0v + acc[ai][bj][m][0] * wv[m], r1v + acc[ai][bj][m][1] * wv[m]); } } } }
    }
};

}

typedef unsigned short bf16;
#define LAS __attribute__((address_space(3)))
typedef float f32x4 __attribute__((ext_vector_type(4)));
typedef float f32x2 __attribute__((ext_vector_type(2)));
constexpr int NB_ = 4, S_ = 8192, T_ = NB_ * S_, D_ = 1024, DR_ = 1408, NBLK_ = 16, BW_ = 88, FF_ = 3584, NE_ = 8;
constexpr int NH_ = 16, DH_ = 64, NG_ = 4, NSA_IN_ = 2608, NSA_PAD_ = 2816, NCMP_ = 512  ;
constexpr float EPS_ = 1e-6f;
constexpr int NTHR = 512, NWAVE = 8;

__device__ __forceinline__ float bf2f(bf16 b) { return __uint_as_float((unsigned)b << 16); }
__device__ __forceinline__ bf16 f2bf(float f) { unsigned u = __float_as_uint(f); return (bf16)((u + 0x7fffu + ((u >> 16) & 1u)) >> 16); }
__device__ __forceinline__ float wave_sum(float v) {
#pragma unroll
    for (int o = 1; o < 64; o <<= 1) v += __shfl_xor(v, o);
    return v;
}
__device__ __forceinline__ float wave_max(float v) {
#pragma unroll
    for (int o = 1; o < 64; o <<= 1) v = fmaxf(v, __shfl_xor(v, o));
    return v;
}
__device__ __forceinline__ int otid() { int t = threadIdx.x; asm volatile("" : "+v"(t)); return t; }
#define WAVE_LDS_SYNC() do { asm volatile("s_waitcnt lgkmcnt(0)" ::: "memory"); __builtin_amdgcn_wave_barrier(); } while (0)

template <bool F8 = false>
__device__ __forceinline__ void convT_job(LAS float* scr  , const float* __restrict__ src, bf16* __restrict__ dst, int K, int N, int Npad, int dst_ld, int dst_koff, int blk, int blk_stride, int row_off,
                                          int G, int bid, float f8scale = 1.0f, const float* __restrict__ kgain = nullptr) {
    const int tid_ = otid(); const int half = tid_ >> 8, t = tid_ & 255, lr = t >> 4, lc4 = t & 15, wn = t >> 2, wk = t & 3;
    const int ncx = (Npad + 63) / 64, ntile = ncx * (K / 64);
    LAS float* tile = scr + half * (64 * 65);
    f32x4 v[4];
    int ti = bid * 2 + half;
    if (ti < ntile) { const int c = (ti % ncx) * 64 + 4 * lc4, k0 = (ti / ncx) * 64;
#pragma unroll
        for (int i = 0; i < 4; ++i) v[i] = (c < N) ? *(const f32x4*)(src + (size_t)(k0 + lr + 16 * i) * N + c) : (f32x4){0.f, 0.f, 0.f, 0.f}; }
    for (int base = bid * 2; base < ntile; base += 2 * G) {
        ti = base + half; const bool ok = ti < ntile; const int c0 = (ti % ncx) * 64, k0 = (ti / ncx) * 64;
        if (ok) {
#pragma unroll
            for (int i = 0; i < 4; ++i)
#pragma unroll
                for (int j = 0; j < 4; ++j) tile[(lr + 16 * i) * 65 + 4 * lc4 + j] = v[i][j];
        }
        const int tn = ti + 2 * G;
        if (tn < ntile) { const int c = (tn % ncx) * 64 + 4 * lc4, kn = (tn / ncx) * 64;
#pragma unroll
            for (int i = 0; i < 4; ++i) v[i] = (c < N) ? *(const f32x4*)(src + (size_t)(kn + lr + 16 * i) * N + c) : (f32x4){0.f, 0.f, 0.f, 0.f}; }
        asm volatile("s_waitcnt lgkmcnt(0)" ::: "memory"); __builtin_amdgcn_s_barrier(); asm volatile("" ::: "memory");
        if (ok) { const int c = c0 + wn;
            if (c < Npad) { int r; if (blk < 0) { const int pnn = c >> 8; const bool rp = (pnn < 5) || pnn == 6 || pnn == 8; r = rp ? (pnn * 256 + 128 * ((c & 63) >> 5) + 32 * ((c & 255) >> 6) + (c & 31)) : c; }
                else r = (c / blk) * blk_stride + (c % blk) + row_off;
                if constexpr (F8) { unsigned w[4];
#pragma unroll
                    for (int j = 0; j < 4; ++j) { const float a0 = tile[(16 * wk + 4 * j) * 65 + wn] * f8scale, a1 = tile[(16 * wk + 4 * j + 1) * 65 + wn] * f8scale, a2 = tile[(16 * wk + 4 * j + 2) * 65 + wn] * f8scale, a3 = tile[(16 * wk + 4 * j + 3) * 65 + wn] * f8scale;
                        w[j] = pg8::pk_fp8x4(a0, a1, a2, a3); }
                    *(uint4*)((unsigned char*)dst + (size_t)r * dst_ld + dst_koff + k0 + 16 * wk) = make_uint4(w[0], w[1], w[2], w[3]); }
                else { unsigned w[8]; float kg[16];
#pragma unroll
                    for (int j = 0; j < 16; ++j) kg[j] = kgain ? kgain[k0 + 16 * wk + j] : 1.0f;
#pragma unroll
                    for (int j = 0; j < 8; ++j) w[j] = (unsigned)f2bf(tile[(16 * wk + 2 * j) * 65 + wn] * kg[2 * j]) | ((unsigned)f2bf(tile[(16 * wk + 2 * j + 1) * 65 + wn] * kg[2 * j + 1]) << 16);
                    uint4* dp = (uint4*)(dst + (size_t)r * dst_ld + dst_koff + k0 + 16 * wk);
                    dp[0] = make_uint4(w[0], w[1], w[2], w[3]); dp[1] = make_uint4(w[4], w[5], w[6], w[7]); } } }
        asm volatile("s_waitcnt lgkmcnt(0)" ::: "memory"); __builtin_amdgcn_s_barrier(); asm volatile("" ::: "memory");
    }
}

__device__ __forceinline__ void moe_conv_fused(LAS float* scr  , const float* __restrict__ wg, const float* __restrict__ wu, const float* __restrict__ wd, unsigned char* __restrict__ ws,
                                               size_t o_mw, size_t mw_stride, int e0, int e1, int G, int bid, float sw, float swd) {
    const int tid_ = otid(); const int half = __builtin_amdgcn_readfirstlane(tid_ >> 8), t = tid_ & 255, lr = t >> 4, lc4 = t & 15, wn = t >> 2, wk = t & 3;
    constexpr int TPM = 896, TPE = 3 * TPM;
    const int ntile = (e1 - e0) * TPE;
    LAS float* tile = scr + half * (64 * 65);
#define MCF_LOAD(ti_) do { const int e_ = e0 + (ti_) / TPE, r_ = (ti_) % TPE, m_ = r_ / TPM, tt_ = r_ % TPM; const int ncx_ = (m_ == 2) ? 16 : 56, N_ = (m_ == 2) ? D_ : FF_; \
        const float* p0_ = (m_ == 0 ? wg : (m_ == 1 ? wu : wd)) + (size_t)e_ * D_ * FF_ + (size_t)((tt_ / ncx_) * 64 + lr) * N_ + (tt_ % ncx_) * 64 + 4 * lc4; \
        _Pragma("unroll") for (int i = 0; i < 4; ++i) v[i] = *(const f32x4*)(p0_ + (size_t)(16 * i) * N_); } while (0)
    f32x4 v[4];
    int ti = bid * 2 + half;
    if (ti < ntile) MCF_LOAD(ti);
    for (int base = bid * 2; base < ntile; base += 2 * G) {
        ti = base + half; const bool ok = ti < ntile;
        if (ok) {
#pragma unroll
            for (int i = 0; i < 4; ++i)
#pragma unroll
                for (int j = 0; j < 4; ++j) tile[(lr + 16 * i) * 65 + 4 * lc4 + j] = v[i][j];
        }
        const int tn = ti + 2 * G;
        if (tn < ntile) MCF_LOAD(tn);
        asm volatile("s_waitcnt lgkmcnt(0)" ::: "memory"); __builtin_amdgcn_s_barrier(); asm volatile("" ::: "memory");
        if (ok) { const int e = e0 + ti / TPE, r_ = ti % TPE, m = r_ / TPM, tt = r_ % TPM; const int ncx = (m == 2) ? 16 : 56, c = (tt % ncx) * 64 + wn, k0 = (tt / ncx) * 64;
            unsigned char* wgu = (e == 7) ? ws : ws + o_mw + (size_t)e * mw_stride;
            const int r = (m == 2) ? c : ((c >> 7) * 256 + (c & 127) + (m == 1 ? 128 : 0)); const int dld = (m == 2) ? FF_ : D_; const float fs = (m == 2) ? swd : sw;
            unsigned char* dst = (m == 2) ? wgu + (size_t)2 * FF_ * D_ : wgu;
            unsigned w[4];
#pragma unroll
            for (int j = 0; j < 4; ++j) { const float a0 = tile[(16 * wk + 4 * j) * 65 + wn] * fs, a1 = tile[(16 * wk + 4 * j + 1) * 65 + wn] * fs, a2 = tile[(16 * wk + 4 * j + 2) * 65 + wn] * fs, a3 = tile[(16 * wk + 4 * j + 3) * 65 + wn] * fs;
                w[j] = pg8::pk_fp8x4(a0, a1, a2, a3); }
            *(uint4*)(dst + (size_t)r * dld + k0 + 16 * wk) = make_uint4(w[0], w[1], w[2], w[3]); }
        asm volatile("s_waitcnt lgkmcnt(0)" ::: "memory"); __builtin_amdgcn_s_barrier(); asm volatile("" ::: "memory");
    }
#undef MCF_LOAD
}

template <bool ROUTE> __device__ __forceinline__ void norm_rows(const float* __restrict__ x, const float* __restrict__ g, bf16* __restrict__ h, const float* __restrict__ wr, float* __restrict__ gates, int G, int bid) {
    const int tid_ = otid(); const int lane = tid_ & 63, gw = bid * NWAVE + (tid_ >> 6), nw = G * NWAVE;
    for (int row = gw; row < T_; row += nw) {
        const f32x4* xr = (const f32x4*)(x + (size_t)row * D_);
        f32x4 v[4]; float ss = 0.f;
#pragma unroll
        for (int j = 0; j < 4; ++j) { v[j] = xr[lane + 64 * j]; ss += v[j][0] * v[j][0] + v[j][1] * v[j][1] + v[j][2] * v[j][2] + v[j][3] * v[j][3]; }
        ss = wave_sum(ss);
        const float rs = 1.0f / sqrtf(ss * (1.0f / D_) + EPS_);
#pragma unroll
        for (int j = 0; j < 4; ++j) { const f32x4 gv = ((const f32x4*)g)[lane + 64 * j];
            v[j] = v[j] * gv * rs;
            uint2 o; o.x = (unsigned)f2bf(v[j][0]) | ((unsigned)f2bf(v[j][1]) << 16); o.y = (unsigned)f2bf(v[j][2]) | ((unsigned)f2bf(v[j][3]) << 16);
            *(uint2*)(h + (size_t)row * D_ + (lane + 64 * j) * 4) = o; }
        if (ROUTE) {
            float lg[8];
#pragma unroll
            for (int e = 0; e < 8; ++e) lg[e] = 0.f;
#pragma unroll
            for (int j = 0; j < 4; ++j) {
#pragma unroll
                for (int i = 0; i < 4; ++i) { const f32x4* w = (const f32x4*)(wr + (size_t)((lane + 64 * j) * 4 + i) * 8); const f32x4 w0 = w[0], w1 = w[1]; const float xv = v[j][i];
                    lg[0] += xv * w0[0]; lg[1] += xv * w0[1]; lg[2] += xv * w0[2]; lg[3] += xv * w0[3];
                    lg[4] += xv * w1[0]; lg[5] += xv * w1[1]; lg[6] += xv * w1[2]; lg[7] += xv * w1[3]; } }
#pragma unroll
            for (int e = 0; e < 8; ++e) lg[e] = wave_sum(lg[e]);
            int i1 = 0; float v1 = lg[0];
#pragma unroll
            for (int e = 1; e < 8; ++e) if (lg[e] > v1) { v1 = lg[e]; i1 = e; }
            int i2 = -1; float v2 = -3.0e38f;
#pragma unroll
            for (int e = 0; e < 8; ++e) if (e != i1 && lg[e] > v2) { v2 = lg[e]; i2 = e; }
            const float w1 = 1.0f / (1.0f + __expf(v2 - v1)), w2 = 1.0f - w1;
            if (lane < 8) gates[(size_t)row * 8 + lane] = (lane == i1) ? w1 : ((lane == i2) ? w2 : 0.f);
        }
    }
}

__device__ __forceinline__ void norm_route_rows(LAS unsigned char* lds, const bf16* __restrict__ x, const float* __restrict__ g, bf16* __restrict__ h, const float* __restrict__ wr, int* __restrict__ cnt,
                                                int* __restrict__ idx, float* __restrict__ wrow, int cap, int G, int bid) {
    LAS int* lcnt = (LAS int*)lds; LAS int* gbase = lcnt + 16; LAS int* rl = gbase + 16; LAS int* rp = rl + 256; LAS int* rt = rp + 256; LAS float* rw = (LAS float*)(rt + 128);
    const int tid = otid(), lane = tid & 63, wv = tid >> 6, gw = bid * NWAVE + wv, nw = G * NWAVE;
    if (tid < 16) lcnt[tid] = 0;
    if (tid < 128) rt[tid] = -1;
    __syncthreads();
    int it = 0;
    pg8::u32x4 pn[2];
#pragma unroll
    for (int j = 0; j < 2; ++j) pn[j] = (gw < T_) ? ((const pg8::u32x4*)(x + (size_t)gw * D_))[lane + 64 * j] : (pg8::u32x4){0u, 0u, 0u, 0u};
    for (int row = gw; row < T_; row += nw, ++it) {
        f32x4 v[4]; float ss = 0.f;
#pragma unroll
        for (int j = 0; j < 2; ++j) pg8::unpack8(pn[j], v[2 * j], v[2 * j + 1]);
        if (row + nw < T_) {
#pragma unroll
            for (int j = 0; j < 2; ++j) pn[j] = ((const pg8::u32x4*)(x + (size_t)(row + nw) * D_))[lane + 64 * j]; }
#pragma unroll
        for (int j = 0; j < 4; ++j) ss += v[j][0] * v[j][0] + v[j][1] * v[j][1] + v[j][2] * v[j][2] + v[j][3] * v[j][3];
        ss = wave_sum(ss);
        const float rs = 1.0f / sqrtf(ss * (1.0f / D_) + EPS_);
#pragma unroll
        for (int j = 0; j < 4; ++j) { const int e0 = (lane + 64 * (j >> 1)) * 8 + 4 * (j & 1); const f32x4 gv = *(const f32x4*)(g + e0);
            v[j] = v[j] * gv * rs;
            *(unsigned*)((unsigned char*)h + (size_t)row * D_ + e0) = pg8::pk_fp8x4(v[j][0] * 16.0f, v[j][1] * 16.0f, v[j][2] * 16.0f, v[j][3] * 16.0f); }
        f32x4 lga = {0.f, 0.f, 0.f, 0.f}, lgb = {0.f, 0.f, 0.f, 0.f};
#pragma unroll
        for (int j = 0; j < 4; ++j) {
#pragma unroll
            for (int i = 0; i < 4; ++i) { const f32x4* w = (const f32x4*)(wr + (size_t)((lane + 64 * (j >> 1)) * 8 + 4 * (j & 1) + i) * 8); const f32x4 w0 = w[0], w1 = w[1]; const float xv = v[j][i];
                lga = w0 * xv + lga; lgb = w1 * xv + lgb; } }
        float lg[8] = {lga[0], lga[1], lga[2], lga[3], lgb[0], lgb[1], lgb[2], lgb[3]};
#pragma unroll
        for (int e = 0; e < 8; ++e) lg[e] = wave_sum(lg[e]);
        int i1 = 0; float v1 = lg[0];
#pragma unroll
        for (int e = 1; e < 8; ++e) if (lg[e] > v1) { v1 = lg[e]; i1 = e; }
        int i2 = -1; float v2 = -3.0e38f;
#pragma unroll
        for (int e = 0; e < 8; ++e) if (e != i1 && lg[e] > v2) { v2 = lg[e]; i2 = e; }
        const float w1 = 1.0f / (1.0f + __expf(v2 - v1)), w2 = 1.0f - w1;
        if (lane == 0 && it < 16) { const int s = wv * 16 + it; const int l1 = i1, l2 = 8 + i2;
            const int p1 = __hip_atomic_fetch_add(lcnt + l1, 1, __ATOMIC_RELAXED, __HIP_MEMORY_SCOPE_WORKGROUP), p2 = __hip_atomic_fetch_add(lcnt + l2, 1, __ATOMIC_RELAXED, __HIP_MEMORY_SCOPE_WORKGROUP);
            rl[s] = l1; rl[128 + s] = l2; rp[s] = p1; rp[128 + s] = p2; rt[s] = row; rw[s] = w1; rw[128 + s] = w2; }
    }
    __syncthreads();
    if (tid < 16) gbase[tid] = __hip_atomic_fetch_add(cnt + tid, lcnt[tid], __ATOMIC_RELAXED, __HIP_MEMORY_SCOPE_AGENT);
    __syncthreads();
    if (tid < 256) { const int k = tid >> 7, s = tid & 127; const int tok = rt[s];
        if (tok >= 0) { const int l = rl[k * 128 + s]; const size_t o = (size_t)l * cap + gbase[l] + rp[k * 128 + s]; idx[o] = tok; wrow[o] = rw[k * 128 + s]; } }
    __syncthreads();
}
__device__ __forceinline__ void cast_rows(const float* __restrict__ x, bf16* __restrict__ sb, float* __restrict__ rs0, int G, int bid) {
    const int tid_ = otid(); const int lane = tid_ & 63, gw = bid * NWAVE + (tid_ >> 6), nw = G * NWAVE;
    for (int row = gw; row < T_; row += 2 * nw) {
        f32x4 v[2][4];
#pragma unroll
        for (int i = 0; i < 2; ++i) { const int r = row + i * nw; if (r < T_) {
#pragma unroll
            for (int j = 0; j < 4; ++j) v[i][j] = *(const f32x4*)(x + (size_t)r * D_ + (lane + 64 * (j >> 1)) * 8 + 4 * (j & 1)); } }
#pragma unroll
        for (int i = 0; i < 2; ++i) { const int r = row + i * nw; if (r < T_) { float ss = 0.f;
#pragma unroll
            for (int j = 0; j < 4; ++j) ss += v[i][j][0] * v[i][j][0] + v[i][j][1] * v[i][j][1] + v[i][j][2] * v[i][j][2] + v[i][j][3] * v[i][j][3];
            ss = wave_sum(ss);
#pragma unroll
            for (int j = 0; j < 2; ++j) ((pg8::u32x4*)(sb + (size_t)r * D_))[lane + 64 * j] = pg8::pack8(v[i][2 * j], v[i][2 * j + 1]);
            if (lane == 0) rs0[r] = 1.0f / sqrtf(ss * (1.0f / D_) + EPS_); } }
    }
}
__device__ __forceinline__ void final_norm_rows(const bf16* __restrict__ x, float* __restrict__ o, const float* __restrict__ g, int G, int bid) {
    const int tid_ = otid(); const int lane = tid_ & 63, gw = bid * NWAVE + (tid_ >> 6), nw = G * NWAVE;
    f32x4 gv[4];
#pragma unroll
    for (int j = 0; j < 4; ++j) gv[j] = *(const f32x4*)(g + (lane + 64 * (j >> 1)) * 8 + 4 * (j & 1));
    for (int row = gw; row < T_; row += 4 * nw) {
        pg8::u32x4 p[4][2];
#pragma unroll
        for (int i = 0; i < 4; ++i) { const int r = row + i * nw; if (r < T_) {
#pragma unroll
            for (int j = 0; j < 2; ++j) p[i][j] = ((const pg8::u32x4*)(x + (size_t)r * D_))[lane + 64 * j]; } }
#pragma unroll
        for (int i = 0; i < 4; ++i) { const int r = row + i * nw; if (r < T_) {
            f32x4 v[4]; float ss = 0.f;
#pragma unroll
            for (int j = 0; j < 2; ++j) pg8::unpack8(p[i][j], v[2 * j], v[2 * j + 1]);
#pragma unroll
            for (int j = 0; j < 4; ++j) ss += v[j][0] * v[j][0] + v[j][1] * v[j][1] + v[j][2] * v[j][2] + v[j][3] * v[j][3];
            ss = wave_sum(ss);
            const float rs = 1.0f / sqrtf(ss * (1.0f / D_) + EPS_);
#pragma unroll
            for (int j = 0; j < 4; ++j) *(f32x4*)(o + (size_t)r * D_ + (lane + 64 * (j >> 1)) * 8 + 4 * (j & 1)) = v[j] * gv[j] * rs; } }
    }
}
__device__ __forceinline__ void norm_rows_b(const bf16* __restrict__ x, const float* __restrict__ g, bf16* __restrict__ h, int G, int bid) {
    const int tid_ = otid(); const int lane = tid_ & 63, gw = bid * NWAVE + (tid_ >> 6), nw = G * NWAVE;
    f32x4 gv[4];
#pragma unroll
    for (int j = 0; j < 4; ++j) gv[j] = *(const f32x4*)(g + (lane + 64 * (j >> 1)) * 8 + 4 * (j & 1));
    for (int row = gw; row < T_; row += 4 * nw) {
        pg8::u32x4 p[4][2];
#pragma unroll
        for (int i = 0; i < 4; ++i) { const int r = row + i * nw; if (r < T_) {
#pragma unroll
            for (int j = 0; j < 2; ++j) p[i][j] = ((const pg8::u32x4*)(x + (size_t)r * D_))[lane + 64 * j]; } }
#pragma unroll
        for (int i = 0; i < 4; ++i) { const int r = row + i * nw; if (r < T_) {
            f32x4 v[4]; float ss = 0.f;
#pragma unroll
            for (int j = 0; j < 2; ++j) pg8::unpack8(p[i][j], v[2 * j], v[2 * j + 1]);
#pragma unroll
            for (int j = 0; j < 4; ++j) ss += v[j][0] * v[j][0] + v[j][1] * v[j][1] + v[j][2] * v[j][2] + v[j][3] * v[j][3];
            ss = wave_sum(ss);
            const float rs = 1.0f / sqrtf(ss * (1.0f / D_) + EPS_);
#pragma unroll
            for (int j = 0; j < 2; ++j) ((pg8::u32x4*)(h + (size_t)r * D_))[lane + 64 * j] = pg8::pack8(v[2 * j] * gv[2 * j] * rs, v[2 * j + 1] * gv[2 * j + 1] * rs); } }
    }
}

__device__ __forceinline__ void rope_table_part(float2* __restrict__ tab, int G, int bid) {
    for (int i = bid * NTHR + otid(); i < S_ * 32; i += G * NTHR) { const int pos = i >> 5, d = i & 31; const float freq = (float)pow(10000.0, -(double)d / 32.0); const float ang = (float)pos * freq;
        tab[i] = make_float2((float)cos((double)ang), (float)sin((double)ang)); }
}
__device__ __forceinline__ void pebias_part(LAS float* red, const float* __restrict__ pe, const float* __restrict__ w1, float* __restrict__ bias1, int G, int bid) {
    const int tid_ = otid();
    for (int o = bid; o < 512; o += G) { const int j = o >> 8, n = o & 255; float s = 0.f;
#pragma unroll
        for (int i = tid_; i < 2048; i += NTHR) s += pe[j * 2048 + i] * w1[((size_t)j * 2048 + i) * 256 + n];
        s = wave_sum(s);
        if ((tid_ & 63) == 0) red[tid_ >> 6] = s;
        __syncthreads();
        if (tid_ == 0) bias1[o] = ((red[0] + red[1]) + (red[2] + red[3])) + ((red[4] + red[5]) + (red[6] + red[7]));
        __syncthreads(); }
}

namespace lru {
#define LRU_LAS __attribute__((address_space(3)))
typedef short bf16x8 __attribute__((ext_vector_type(8)));
typedef float f32x4 __attribute__((ext_vector_type(4)));
typedef float f32x2 __attribute__((ext_vector_type(2)));
constexpr int CHT = 256, APITCH = 208  , A_BYTES = CHT * APITCH, WS_OFF = A_BYTES, DUMP_OFF = A_BYTES + 2 * 2048  , LDS_BYTES = DUMP_OFF + 8192;
#define LRU_GAS __attribute__((address_space(1)))
__device__ __forceinline__ LRU_GAS char* sptr(const char* p) { unsigned long v = (unsigned long)p; asm("" : "+s"(v)); return (LRU_GAS char*)v; }
__device__ __forceinline__ unsigned cvtpk(float lo, float hi) { unsigned r; asm("v_cvt_pk_bf16_f32 %0, %1, %2" : "=v"(r) : "v"(lo), "v"(hi)); return r; }
__device__ __forceinline__ void lru_unit(LRU_LAS unsigned char* lds, int u, const bf16* __restrict__ proj, const float* __restrict__ conv_w, const float* __restrict__ conv_b, const float* __restrict__ w_a,
                                         const float* __restrict__ b_a, const float* __restrict__ w_i, const float* __restrict__ b_i, const float* __restrict__ lam, bf16* __restrict__ y) {
    int tid_raw = threadIdx.x; asm volatile("" : "+v"(tid_raw));
    const int tid = tid_raw, lane = tid & 63, w = __builtin_amdgcn_readfirstlane(tid >> 6), col = lane & 15, fq = lane >> 4;
    const int b = u >> 6, n = (u >> 2) & 15, q = u & 3;
    constexpr float L2E = 1.4426950408889634f;
    bf16x8 Ba[2][3], Bi[2][3];
#pragma unroll
    for (int nt = 0; nt < 2; ++nt)
#pragma unroll
        for (int ks = 0; ks < 3; ++ks)
#pragma unroll
            for (int i = 0; i < 8; ++i) { const int k = 32 * ks + 8 * fq + i, d = 16 * nt + col; const bool ok = (k < BW_) && (d < 22);
                const size_t off = (size_t)(n * BW_ + (ok ? k : 0)) * BW_ + 22 * q + (ok ? d : 0);
                const float mk = ok ? -L2E : 0.f;
                Ba[nt][ks][i] = (short)f2bf(mk * w_a[off]); Bi[nt][ks][i] = (short)f2bf(mk * w_i[off]); }
    float ba[2], bi[2], c2[2]; bool vch[2]; int dch[2];
#pragma unroll
    for (int nt = 0; nt < 2; ++nt) { const int d = 16 * nt + col; vch[nt] = d < 22; dch[nt] = vch[nt] ? d : 0; const int ch = n * BW_ + 22 * q + dch[nt];
        ba[nt] = -L2E * b_a[ch]; bi[nt] = -L2E * b_i[ch]; c2[nt] = -8.0f * L2E * log1pf(expf(-lam[ch])); }
    const bool cact = lane < 44; const int cch = n * BW_ + 2 * (cact ? lane : 0);
    f32x2 cw[4], cb;
#pragma unroll
    for (int k = 0; k < 4; ++k) { cw[k].x = cact ? conv_w[k * DR_ + cch] : 0.f; cw[k].y = cact ? conv_w[k * DR_ + cch + 1] : 0.f; }
    cb.x = cact ? conv_b[cch] : 0.f; cb.y = cact ? conv_b[cch + 1] : 0.f;
    float hc[2] = {0.f, 0.f};
    const char* uxr = (const char*)proj + ((size_t)b * S_ * (2 * DR_) + DR_ + n * BW_) * 2;   const unsigned vxr = cact ? 4u * lane : 0u;
    const char* ugt = (const char*)proj + ((size_t)b * S_ * (2 * DR_) + n * BW_ + 22 * q) * 2;
    char* uy = (char*)y + ((size_t)b * S_ * DR_ + n * BW_ + 22 * q) * 2;
    unsigned vgt[2], vy[2];
#pragma unroll
    for (int nt = 0; nt < 2; ++nt) { vgt[nt] = (unsigned)(4 * fq * (2 * DR_) + dch[nt]) * 2u; vy[nt] = (unsigned)(4 * fq * DR_ + dch[nt]) * 2u; }
    LRU_LAS unsigned char* At = lds;
    LRU_LAS unsigned char* cwr = (lane < 48) ? At + 32 * w * APITCH + 4 * lane : lds + DUMP_OFF + 4 * lane;
    unsigned xr[35];
#pragma unroll
    for (int r = 0; r < 35; ++r) { const int t = 32 * w - 3 + r; xr[r] = (t >= 0) ? *(const unsigned*)(uxr + (size_t)(t >= 0 ? t : 0) * (2 * DR_ * 2) + vxr) : 0u; }
    for (int c = 0; c < S_ / CHT; ++c) {
        const int t0 = c * CHT;
        bf16 gt[2][2][4]; unsigned vg0 = vgt[0], vg1 = vgt[1]; asm volatile("" : "+v"(vg0), "+v"(vg1));
#pragma unroll
        for (int mt = 0; mt < 2; ++mt)
#pragma unroll
            for (int j = 0; j < 4; ++j) { const LRU_GAS char* rowp = sptr(ugt + (size_t)(t0 + 32 * w + 16 * mt + j) * (2 * DR_ * 2));
#pragma unroll
                for (int nt = 0; nt < 2; ++nt) gt[mt][nt][j] = *(const LRU_GAS bf16*)(rowp + (nt ? vg1 : vg0)); }
        {
            f32x2 xu[35];
#pragma unroll
            for (int r = 0; r < 35; ++r) { xu[r].x = __uint_as_float(xr[r] << 16); xu[r].y = __uint_as_float(xr[r] & 0xffff0000u); }
#pragma unroll
            for (int r = 0; r < 32; ++r) {
                f32x2 x = cb;
#pragma unroll
                for (int k = 0; k < 4; ++k) x = __builtin_elementwise_fma(cw[k], xu[r + k], x);
                *(LRU_LAS unsigned*)(cwr + r * APITCH) = cvtpk(x.x, x.y);
            }
        }
        if (c + 1 < S_ / CHT) {
            const char* rowp = uxr + (size_t)(t0 + CHT + 32 * w - 3) * (2 * DR_ * 2); unsigned vx = vxr; asm volatile("" : "+v"(vx));
#pragma unroll
            for (int r = 0; r < 35; ++r) xr[r] = *(const LRU_GAS unsigned*)(sptr(rowp + (size_t)r * (2 * DR_ * 2)) + vx);
        }
        asm volatile("s_waitcnt lgkmcnt(0)" ::: "memory");
        f32x4 aa[2][2], ai[2][2];
#pragma unroll
        for (int mt = 0; mt < 2; ++mt)
#pragma unroll
            for (int nt = 0; nt < 2; ++nt) { aa[mt][nt] = (f32x4){ba[nt], ba[nt], ba[nt], ba[nt]}; ai[mt][nt] = (f32x4){bi[nt], bi[nt], bi[nt], bi[nt]}; }
#pragma unroll
        for (int mt = 0; mt < 2; ++mt)
#pragma unroll
            for (int ks = 0; ks < 3; ++ks) { const bf16x8 af = *(const LRU_LAS bf16x8*)(At + (32 * w + 16 * mt + col) * APITCH + (32 * ks + 8 * fq) * 2);
#pragma unroll
                for (int nt = 0; nt < 2; ++nt) { aa[mt][nt] = __builtin_amdgcn_mfma_f32_16x16x32_bf16(af, Ba[nt][ks], aa[mt][nt], 0, 0, 0);
                                                 ai[mt][nt] = __builtin_amdgcn_mfma_f32_16x16x32_bf16(af, Bi[nt][ks], ai[mt][nt], 0, 0, 0); } }
        const bool first = (c == 0) && (w == 0) && (fq == 0);
        float hl[2][2][4], ca[2][2][4];
#pragma unroll
        for (int mt = 0; mt < 2; ++mt)
#pragma unroll
            for (int nt = 0; nt < 2; ++nt) { float hprev = 0.f, aprev = 1.f;
                f32x4 e1 = aa[mt][nt], e2 = ai[mt][nt], xc4;
#pragma unroll
                for (int j = 0; j < 4; ++j) { e1[j] = __builtin_amdgcn_exp2f(e1[j]); e2[j] = __builtin_amdgcn_exp2f(e2[j]);
                    xc4[j] = bf2f(*(const LRU_LAS bf16*)(At + (32 * w + 16 * mt + 4 * fq + j) * APITCH + (22 * q + dch[nt]) * 2)); }
                f32x4 r4 = e1 + 1.0f, ig4 = e2 + 1.0f;
#pragma unroll
                for (int j = 0; j < 4; ++j) { r4[j] = __builtin_amdgcn_rcpf(r4[j]); ig4[j] = __builtin_amdgcn_rcpf(ig4[j]); }
                f32x4 a4 = r4 * c2[nt];
#pragma unroll
                for (int j = 0; j < 4; ++j) a4[j] = __builtin_amdgcn_exp2f(a4[j]);
                f32x4 m4 = 1.0f - a4 * a4;
#pragma unroll
                for (int j = 0; j < 4; ++j) m4[j] = __builtin_amdgcn_sqrtf(fmaxf(m4[j], 0.f));
                if (mt == 0) m4[0] = first ? 1.0f : m4[0];
                const f32x4 uu4 = m4 * (ig4 * xc4);
#pragma unroll
                for (int j = 0; j < 4; ++j) { hprev = a4[j] * hprev + uu4[j]; aprev = a4[j] * aprev; hl[mt][nt][j] = hprev; ca[mt][nt][j] = aprev; } }
        float exA[2][2], exH[2][2], wA[2], wH[2];
#pragma unroll
        for (int nt = 0; nt < 2; ++nt) { float tA[2], tH[2];
#pragma unroll
            for (int mt = 0; mt < 2; ++mt) { float A = ca[mt][nt][3], H = hl[mt][nt][3];
                float Ap = __shfl_up(A, 16), Hp = __shfl_up(H, 16); if (fq >= 1) { H = A * Hp + H; A = A * Ap; }
                Ap = __shfl_up(A, 32); Hp = __shfl_up(H, 32); if (fq >= 2) { H = A * Hp + H; A = A * Ap; }
                const float eA = __shfl_up(A, 16), eH = __shfl_up(H, 16); exA[mt][nt] = fq ? eA : 1.0f; exH[mt][nt] = fq ? eH : 0.f;
                tA[mt] = __shfl(A, col + 48); tH[mt] = __shfl(H, col + 48); }
            exH[1][nt] = exA[1][nt] * tH[0] + exH[1][nt]; exA[1][nt] = exA[1][nt] * tA[0];
            wA[nt] = tA[1] * tA[0]; wH[nt] = tA[1] * tH[0] + tH[1]; }
        LRU_LAS f32x2* ws = (LRU_LAS f32x2*)(lds + WS_OFF + (c & 1) * 2048);
        if (fq == 0) { ws[w * 32 + col] = (f32x2){wA[0], wH[0]}; ws[w * 32 + 16 + col] = (f32x2){wA[1], wH[1]}; }
        asm volatile("s_waitcnt lgkmcnt(0)" ::: "memory");
        __builtin_amdgcn_s_barrier();
        asm volatile("" ::: "memory");
        unsigned o[2][2][2];
#pragma unroll
        for (int nt = 0; nt < 2; ++nt) { float cin = hc[nt], cend = hc[nt];
#pragma unroll
            for (int ww = 0; ww < 8; ++ww) { const f32x2 s = ws[ww * 32 + 16 * nt + col]; cend = s.x * cend + s.y; if (ww < w) cin = cend; }
            hc[nt] = cend;
#pragma unroll
            for (int mt = 0; mt < 2; ++mt) { const float sc = exA[mt][nt] * cin + exH[mt][nt];
#pragma unroll
                for (int j2 = 0; j2 < 2; ++j2) o[nt][mt][j2] = cvtpk((hl[mt][nt][2 * j2] + ca[mt][nt][2 * j2] * sc) * bf2f(gt[mt][nt][2 * j2]), (hl[mt][nt][2 * j2 + 1] + ca[mt][nt][2 * j2 + 1] * sc) * bf2f(gt[mt][nt][2 * j2 + 1])); } }
#pragma unroll
        for (int nt = 0; nt < 2; ++nt)
            if (vch[nt]) { unsigned vyo = vy[nt]; asm volatile("" : "+v"(vyo));
#pragma unroll
                for (int mt = 0; mt < 2; ++mt)
#pragma unroll
                    for (int j2 = 0; j2 < 2; ++j2) { LRU_GAS char* rowp = sptr(uy + (size_t)(t0 + 32 * w + 16 * mt + 2 * j2) * (DR_ * 2));
                        *(LRU_GAS bf16*)(rowp + vyo) = (bf16)(o[nt][mt][j2] & 0xffffu); *(LRU_GAS bf16*)(rowp + DR_ * 2 + vyo) = (bf16)(o[nt][mt][j2] >> 16); } }
    }
}
}

namespace nsa {
typedef short bf16x8 __attribute__((ext_vector_type(8)));
typedef short s16x4 __attribute__((ext_vector_type(4)));
typedef unsigned u32x4 __attribute__((ext_vector_type(4)));
typedef float f32x8 __attribute__((ext_vector_type(8)));
typedef __bf16 bf16x8n __attribute__((ext_vector_type(8)));
constexpr int TILE_B = 64 * 128, BUF_B = 2 * TILE_B, NBUF = 4;
constexpr int OFF_G = NBUF * BUF_B, OFF_E3 = OFF_G + 32768;
constexpr int OFF_ACC = OFF_G, OFF_ML = OFF_ACC + 65536, OFF_AM = OFF_ML + 2048, OFF_QL = OFF_AM + 1024, OFF_QC = OFF_QL + 4096, OFF_TL = OFF_QC + 256, OFF_SEL = OFF_TL + 128, OFF_UNI = OFF_SEL + 1024, OFF_REC = OFF_UNI + 64  , OFF_END = OFF_REC + 2048;
static_assert(OFF_E3 + 32768 <= OFF_ML && OFF_END <= 159744, "attention LDS map");
constexpr int SEL_DENSE_QB = 28;
__device__ __forceinline__ int swz(int row, int chunk) { return row * 128 + ((chunk ^ ((row >> 1) & 7)) << 4); }
#define NSA_NEG (-INFINITY)

__device__ __forceinline__ unsigned pk_bf16(float lo, float hi) { unsigned r; asm volatile("v_cvt_pk_bf16_f32 %0, %1, %2" : "=v"(r) : "v"(lo), "v"(hi)); return r; }

__device__ __forceinline__ float xmax16(float x) { const auto r = __builtin_amdgcn_permlane16_swap(__float_as_uint(x), __float_as_uint(x), false, false); return fmaxf(__uint_as_float(r[0]), __uint_as_float(r[1])); }
__device__ __forceinline__ float xmax32(float x) { const auto r = __builtin_amdgcn_permlane32_swap(__float_as_uint(x), __float_as_uint(x), false, false); return fmaxf(__uint_as_float(r[0]), __uint_as_float(r[1])); }
__device__ __forceinline__ float xsum16(float x) { const auto r = __builtin_amdgcn_permlane16_swap(__float_as_uint(x), __float_as_uint(x), false, false); return __uint_as_float(r[0]) + __uint_as_float(r[1]); }
__device__ __forceinline__ float xsum32(float x) { const auto r = __builtin_amdgcn_permlane32_swap(__float_as_uint(x), __float_as_uint(x), false, false); return __uint_as_float(r[0]) + __uint_as_float(r[1]); }
__device__ __forceinline__ float qx1(float x) { return __uint_as_float((unsigned)__builtin_amdgcn_update_dpp(0, (int)__float_as_uint(x), 0xB1, 0xF, 0xF, false)); }
__device__ __forceinline__ float qx2(float x) { return __uint_as_float((unsigned)__builtin_amdgcn_update_dpp(0, (int)__float_as_uint(x), 0x4E, 0xF, 0xF, false)); }
constexpr float LOG2E = 1.4426950408889634f;
template <int MODE, bool MASKED>
__device__ __forceinline__ void visit(const LAS unsigned char* Kt, const LAS unsigned char* Vt, const bool (&act)[2], const bool (&on)[2], const bf16x8 (&Qf)[2][2], const int (&klo)[2], const int (&khi)[2],
                                      float (&m)[2], float (&l)[2], f32x4 (&O)[2][4], const float (&invl)[2], LAS float* Gs, LAS float* E3s, int nbase, int col, int fq) {
    f32x4 S[2][4];
    const f32x4 zero4 = {0.f, 0.f, 0.f, 0.f};
#pragma unroll
    for (int kt = 0; kt < 4; ++kt) { const bf16x8 kf0 = *(const LAS bf16x8*)(Kt + swz(16 * kt + col, fq)), kf1 = *(const LAS bf16x8*)(Kt + swz(16 * kt + col, 4 + fq));
        if (act[0]) { S[0][kt] = __builtin_amdgcn_mfma_f32_16x16x32_bf16(kf0, Qf[0][0], zero4, 0, 0, 0); S[0][kt] = __builtin_amdgcn_mfma_f32_16x16x32_bf16(kf1, Qf[0][1], S[0][kt], 0, 0, 0); }
        if (act[1]) { S[1][kt] = __builtin_amdgcn_mfma_f32_16x16x32_bf16(kf0, Qf[1][0], zero4, 0, 0, 0); S[1][kt] = __builtin_amdgcn_mfma_f32_16x16x32_bf16(kf1, Qf[1][1], S[1][kt], 0, 0, 0); } }
    bf16x8 P[2][2];
#pragma unroll
    for (int cg = 0; cg < 2; ++cg) {
        if (act[cg]) {
            if (MASKED) {
#pragma unroll
                for (int kt = 0; kt < 4; ++kt)
#pragma unroll
                    for (int j = 0; j < 4; ++j) { const int key = 16 * kt + 4 * fq + j; if (key < klo[cg] || key > khi[cg]) S[cg][kt][j] = NSA_NEG; }
            }
            float nb;
            if (MODE == 2) { nb = (m[cg] == NSA_NEG) ? 0.f : -m[cg] * LOG2E; }
            else {
                float mx = fmaxf(fmaxf(S[cg][0][0], S[cg][0][1]), S[cg][0][2]);
                mx = fmaxf(fmaxf(mx, S[cg][0][3]), S[cg][1][0]); mx = fmaxf(fmaxf(mx, S[cg][1][1]), S[cg][1][2]); mx = fmaxf(fmaxf(mx, S[cg][1][3]), S[cg][2][0]);
                mx = fmaxf(fmaxf(mx, S[cg][2][1]), S[cg][2][2]); mx = fmaxf(fmaxf(mx, S[cg][2][3]), S[cg][3][0]); mx = fmaxf(fmaxf(mx, S[cg][3][1]), S[cg][3][2]); mx = fmaxf(mx, S[cg][3][3]);
                mx = xmax16(mx); mx = xmax32(mx);
                if (!MASKED) mx = on[cg] ? mx : NSA_NEG;
                const float mnew = fmaxf(m[cg], mx), msafe = (mnew == NSA_NEG) ? 0.f : mnew;
                nb = -msafe * LOG2E;
                if (__ballot(mnew != m[cg]) != 0ull) {
                    const float alpha = __builtin_amdgcn_exp2f((m[cg] - msafe) * LOG2E);
                    m[cg] = mnew; l[cg] *= alpha;
                    if (MODE == 0) {
#pragma unroll
                        for (int dt = 0; dt < 4; ++dt) O[cg][dt] = O[cg][dt] * alpha; } }
            }
            if (!MASKED) nb = on[cg] ? nb : NSA_NEG;
            f32x4 ls4 = (f32x4){0.f, 0.f, 0.f, 0.f};
#pragma unroll
            for (int kt = 0; kt < 4; ++kt) { f32x4 a = S[cg][kt] * LOG2E + nb;
                a[0] = __builtin_amdgcn_exp2f(a[0]); a[1] = __builtin_amdgcn_exp2f(a[1]); a[2] = __builtin_amdgcn_exp2f(a[2]); a[3] = __builtin_amdgcn_exp2f(a[3]);
                if (MODE == 2) a = a * invl[cg];
                S[cg][kt] = a; ls4 = ls4 + a; }
            if (MODE != 2) l[cg] += (ls4[0] + ls4[1]) + (ls4[2] + ls4[3]);
            if (MODE != 1) {
#pragma unroll
                for (int kp = 0; kp < 2; ++kp) { const f32x4 a = S[cg][2 * kp], c = S[cg][2 * kp + 1]; const f32x8 f = {a[0], a[1], a[2], a[3], c[0], c[1], c[2], c[3]};
                    P[cg][kp] = __builtin_bit_cast(bf16x8, __builtin_convertvector(f, bf16x8n)); }
            }
            if (MODE == 2) {
#pragma unroll
                for (int kt = 0; kt < 4; ++kt) { float gs = 2.f * (S[cg][kt][0] + S[cg][kt][1] + S[cg][kt][2]) + S[cg][kt][3], e3 = S[cg][kt][3];
                    gs += qx1(gs); gs += qx2(gs); e3 += qx1(e3); e3 += qx2(e3);
                    if ((col & 3) == 0) { const int o = (4 * cg + (col >> 2)) * 128 + nbase + 4 * kt + fq; Gs[o] = gs; E3s[o] = e3; } }
            }
        }
    }
    if (MODE != 1) {
#pragma unroll
        for (int dt = 0; dt < 4; ++dt)
#pragma unroll
            for (int kp = 0; kp < 2; ++kp) { const int vr0 = 32 * kp + 4 * fq + (col >> 2), vch = 2 * dt + ((col & 3) >> 1), vh = (col & 1) * 8;
                const s16x4 v0 = __builtin_amdgcn_ds_read_tr16_b64_v4i16((LAS s16x4*)(Vt + swz(vr0, vch) + vh)), v1 = __builtin_amdgcn_ds_read_tr16_b64_v4i16((LAS s16x4*)(Vt + swz(vr0 + 16, vch) + vh));
                const bf16x8 vf = {v0[0], v0[1], v0[2], v0[3], v1[0], v1[1], v1[2], v1[3]};
                if (act[0]) O[0][dt] = __builtin_amdgcn_mfma_f32_16x16x32_bf16(vf, P[0][kp], O[0][dt], 0, 0, 0);
                if (act[1]) O[1][dt] = __builtin_amdgcn_mfma_f32_16x16x32_bf16(vf, P[1][kp], O[1][dt], 0, 0, 0); }
    }
}

template <int MODE>
__device__ __forceinline__ void visitw(const LAS unsigned char* Ka, const LAS unsigned char* Va, const LAS unsigned char* Kb, const LAS unsigned char* Vb, const bf16x8 (&Qf)[2][2],
                                       float (&m)[2], float (&l)[2], f32x4 (&O)[2][4], const float (&invl)[2], LAS float* Gs, LAS float* E3s, int nbase_a, int nbase_b, int col, int fq) {
    f32x4 Sa[2][4], Sb[2][4];
    const f32x4 zero4 = {0.f, 0.f, 0.f, 0.f};
#pragma unroll
    for (int kt = 0; kt < 4; ++kt) { const bf16x8 kf0 = *(const LAS bf16x8*)(Ka + swz(16 * kt + col, fq)), kf1 = *(const LAS bf16x8*)(Ka + swz(16 * kt + col, 4 + fq));
        Sa[0][kt] = __builtin_amdgcn_mfma_f32_16x16x32_bf16(kf0, Qf[0][0], zero4, 0, 0, 0); Sa[0][kt] = __builtin_amdgcn_mfma_f32_16x16x32_bf16(kf1, Qf[0][1], Sa[0][kt], 0, 0, 0);
        Sa[1][kt] = __builtin_amdgcn_mfma_f32_16x16x32_bf16(kf0, Qf[1][0], zero4, 0, 0, 0); Sa[1][kt] = __builtin_amdgcn_mfma_f32_16x16x32_bf16(kf1, Qf[1][1], Sa[1][kt], 0, 0, 0); }
#pragma unroll
    for (int kt = 0; kt < 4; ++kt) { const bf16x8 kf0 = *(const LAS bf16x8*)(Kb + swz(16 * kt + col, fq)), kf1 = *(const LAS bf16x8*)(Kb + swz(16 * kt + col, 4 + fq));
        Sb[0][kt] = __builtin_amdgcn_mfma_f32_16x16x32_bf16(kf0, Qf[0][0], zero4, 0, 0, 0); Sb[0][kt] = __builtin_amdgcn_mfma_f32_16x16x32_bf16(kf1, Qf[0][1], Sb[0][kt], 0, 0, 0);
        Sb[1][kt] = __builtin_amdgcn_mfma_f32_16x16x32_bf16(kf0, Qf[1][0], zero4, 0, 0, 0); Sb[1][kt] = __builtin_amdgcn_mfma_f32_16x16x32_bf16(kf1, Qf[1][1], Sb[1][kt], 0, 0, 0); }
    bf16x8 Pa[2][2], Pb[2][2];
#pragma unroll
    for (int cg = 0; cg < 2; ++cg) {
        float nb;
        if (MODE == 2) { nb = (m[cg] == NSA_NEG) ? 0.f : -m[cg] * LOG2E; }
        else {
            float mx = fmaxf(fmaxf(Sa[cg][0][0], Sa[cg][0][1]), Sa[cg][0][2]);
            mx = fmaxf(fmaxf(mx, Sa[cg][0][3]), Sa[cg][1][0]); mx = fmaxf(fmaxf(mx, Sa[cg][1][1]), Sa[cg][1][2]); mx = fmaxf(fmaxf(mx, Sa[cg][1][3]), Sa[cg][2][0]);
            mx = fmaxf(fmaxf(mx, Sa[cg][2][1]), Sa[cg][2][2]); mx = fmaxf(fmaxf(mx, Sa[cg][2][3]), Sa[cg][3][0]); mx = fmaxf(fmaxf(mx, Sa[cg][3][1]), Sa[cg][3][2]); mx = fmaxf(mx, Sa[cg][3][3]);
            mx = fmaxf(fmaxf(mx, Sb[cg][0][0]), Sb[cg][0][1]); mx = fmaxf(fmaxf(mx, Sb[cg][0][2]), Sb[cg][0][3]); mx = fmaxf(fmaxf(mx, Sb[cg][1][0]), Sb[cg][1][1]); mx = fmaxf(fmaxf(mx, Sb[cg][1][2]), Sb[cg][1][3]);
            mx = fmaxf(fmaxf(mx, Sb[cg][2][0]), Sb[cg][2][1]); mx = fmaxf(fmaxf(mx, Sb[cg][2][2]), Sb[cg][2][3]); mx = fmaxf(fmaxf(mx, Sb[cg][3][0]), Sb[cg][3][1]); mx = fmaxf(fmaxf(mx, Sb[cg][3][2]), Sb[cg][3][3]);
            mx = xmax16(mx); mx = xmax32(mx);
            const float mnew = fmaxf(m[cg], mx), msafe = (mnew == NSA_NEG) ? 0.f : mnew;
            nb = -msafe * LOG2E;
            if (__ballot(mnew != m[cg]) != 0ull) {
                const float alpha = __builtin_amdgcn_exp2f((m[cg] - msafe) * LOG2E);
                m[cg] = mnew; l[cg] *= alpha;
                if (MODE == 0) {
#pragma unroll
                    for (int dt = 0; dt < 4; ++dt) O[cg][dt] = O[cg][dt] * alpha; } }
        }
        f32x4 ls4 = (f32x4){0.f, 0.f, 0.f, 0.f};
#pragma unroll
        for (int kt = 0; kt < 4; ++kt) { f32x4 a = Sa[cg][kt] * LOG2E + nb;
            a[0] = __builtin_amdgcn_exp2f(a[0]); a[1] = __builtin_amdgcn_exp2f(a[1]); a[2] = __builtin_amdgcn_exp2f(a[2]); a[3] = __builtin_amdgcn_exp2f(a[3]);
            if (MODE == 2) a = a * invl[cg];
            Sa[cg][kt] = a; ls4 = ls4 + a; }
#pragma unroll
        for (int kt = 0; kt < 4; ++kt) { f32x4 a = Sb[cg][kt] * LOG2E + nb;
            a[0] = __builtin_amdgcn_exp2f(a[0]); a[1] = __builtin_amdgcn_exp2f(a[1]); a[2] = __builtin_amdgcn_exp2f(a[2]); a[3] = __builtin_amdgcn_exp2f(a[3]);
            if (MODE == 2) a = a * invl[cg];
            Sb[cg][kt] = a; ls4 = ls4 + a; }
        if (MODE != 2) l[cg] += (ls4[0] + ls4[1]) + (ls4[2] + ls4[3]);
        if (MODE != 1) {
#pragma unroll
            for (int kp = 0; kp < 2; ++kp) { const f32x4 a = Sa[cg][2 * kp], c = Sa[cg][2 * kp + 1]; const f32x8 f = {a[0], a[1], a[2], a[3], c[0], c[1], c[2], c[3]};
                Pa[cg][kp] = __builtin_bit_cast(bf16x8, __builtin_convertvector(f, bf16x8n)); }
#pragma unroll
            for (int kp = 0; kp < 2; ++kp) { const f32x4 a = Sb[cg][2 * kp], c = Sb[cg][2 * kp + 1]; const f32x8 f = {a[0], a[1], a[2], a[3], c[0], c[1], c[2], c[3]};
                Pb[cg][kp] = __builtin_bit_cast(bf16x8, __builtin_convertvector(f, bf16x8n)); }
        }
        if (MODE == 2) {
#pragma unroll
            for (int kt = 0; kt < 4; ++kt) { float gs = 2.f * (Sa[cg][kt][0] + Sa[cg][kt][1] + Sa[cg][kt][2]) + Sa[cg][kt][3], e3 = Sa[cg][kt][3];
                gs += qx1(gs); gs += qx2(gs); e3 += qx1(e3); e3 += qx2(e3);
                if ((col & 3) == 0) { const int o = (4 * cg + (col >> 2)) * 128 + nbase_a + 4 * kt + fq; Gs[o] = gs; E3s[o] = e3; } }
#pragma unroll
            for (int kt = 0; kt < 4; ++kt) { float gs = 2.f * (Sb[cg][kt][0] + Sb[cg][kt][1] + Sb[cg][kt][2]) + Sb[cg][kt][3], e3 = Sb[cg][kt][3];
                gs += qx1(gs); gs += qx2(gs); e3 += qx1(e3); e3 += qx2(e3);
                if ((col & 3) == 0) { const int o = (4 * cg + (col >> 2)) * 128 + nbase_b + 4 * kt + fq; Gs[o] = gs; E3s[o] = e3; } }
        }
    }
    if (MODE != 1) {
#pragma unroll
        for (int dt = 0; dt < 4; ++dt)
#pragma unroll
            for (int kp = 0; kp < 2; ++kp) { const int vr0 = 32 * kp + 4 * fq + (col >> 2), vch = 2 * dt + ((col & 3) >> 1), vh = (col & 1) * 8;
                const s16x4 v0 = __builtin_amdgcn_ds_read_tr16_b64_v4i16((LAS s16x4*)(Va + swz(vr0, vch) + vh)), v1 = __builtin_amdgcn_ds_read_tr16_b64_v4i16((LAS s16x4*)(Va + swz(vr0 + 16, vch) + vh));
                const bf16x8 vf = {v0[0], v0[1], v0[2], v0[3], v1[0], v1[1], v1[2], v1[3]};
                O[0][dt] = __builtin_amdgcn_mfma_f32_16x16x32_bf16(vf, Pa[0][kp], O[0][dt], 0, 0, 0);
                O[1][dt] = __builtin_amdgcn_mfma_f32_16x16x32_bf16(vf, Pa[1][kp], O[1][dt], 0, 0, 0); }
#pragma unroll
        for (int dt = 0; dt < 4; ++dt)
#pragma unroll
            for (int kp = 0; kp < 2; ++kp) { const int vr0 = 32 * kp + 4 * fq + (col >> 2), vch = 2 * dt + ((col & 3) >> 1), vh = (col & 1) * 8;
                const s16x4 v0 = __builtin_amdgcn_ds_read_tr16_b64_v4i16((LAS s16x4*)(Vb + swz(vr0, vch) + vh)), v1 = __builtin_amdgcn_ds_read_tr16_b64_v4i16((LAS s16x4*)(Vb + swz(vr0 + 16, vch) + vh));
                const bf16x8 vf = {v0[0], v0[1], v0[2], v0[3], v1[0], v1[1], v1[2], v1[3]};
                O[0][dt] = __builtin_amdgcn_mfma_f32_16x16x32_bf16(vf, Pb[0][kp], O[0][dt], 0, 0, 0);
                O[1][dt] = __builtin_amdgcn_mfma_f32_16x16x32_bf16(vf, Pb[1][kp], O[1][dt], 0, 0, 0); }
    }
}

template <class Src, class Body>
__device__ __forceinline__ void stream(LAS unsigned char* lds, int ntiles, int tid, Src src, Body body, bool pre = false) {
    if (ntiles <= 0) return;
    const int lane = tid & 63, wv = __builtin_amdgcn_readfirstlane(tid >> 6);
    const int row = 8 * wv + (lane >> 3), chs = (lane & 7) ^ ((row >> 1) & 7);
#define NSA_ISSUE(i_) do { const bf16* kp_; const bf16* vp_; int kpi_, vpi_; src((i_), kp_, vp_, kpi_, vpi_); LAS unsigned char* b_ = lds + ((i_) & (NBUF - 1)) * BUF_B + wv * 1024; \
        __builtin_amdgcn_global_load_lds((const unsigned*)(kp_ + (size_t)row * kpi_ + chs * 8), (LAS unsigned*)b_, 16, 0, 0); \
        __builtin_amdgcn_global_load_lds((const unsigned*)(vp_ + (size_t)row * vpi_ + chs * 8), (LAS unsigned*)(b_ + TILE_B), 16, 0, 0); } while (0)
    asm volatile("s_waitcnt vmcnt(0)" ::: "memory");
    if (!pre) { NSA_ISSUE(0); if (ntiles > 1) NSA_ISSUE(1); if (ntiles > 2) NSA_ISSUE(2); }
    for (int i = 0; i < ntiles; ++i) {
        const int ahead = ntiles - 1 - i;
        if (ahead >= 2) asm volatile("s_waitcnt vmcnt(4)" ::: "memory"); else if (ahead == 1) asm volatile("s_waitcnt vmcnt(2)" ::: "memory"); else asm volatile("s_waitcnt vmcnt(0)" ::: "memory");
        __builtin_amdgcn_s_barrier();
        asm volatile("" ::: "memory");
        LAS unsigned char* cur = lds + (i & (NBUF - 1)) * BUF_B;
        body(i, (const LAS unsigned char*)cur, (const LAS unsigned char*)(cur + TILE_B));
        if (i + 3 < ntiles) NSA_ISSUE(i + 3);
    }
    asm volatile("s_waitcnt lgkmcnt(0)" ::: "memory");
    __builtin_amdgcn_s_barrier();
    asm volatile("" ::: "memory");
#undef NSA_ISSUE
}
template <class Src, class Body>
__device__ __forceinline__ void stream2(LAS unsigned char* lds, int ntiles, int tid, Src src, Body body) {
    if (ntiles <= 0) return;
    const int lane = tid & 63, wv = __builtin_amdgcn_readfirstlane(tid >> 6);
    const int row = 8 * wv + (lane >> 3), chs = (lane & 7) ^ ((row >> 1) & 7);
#define NSA_ISSUE2(i_) do { const bf16* kp_; const bf16* vp_; int kpi_, vpi_; src((i_), kp_, vp_, kpi_, vpi_); LAS unsigned char* b_ = lds + ((i_) & (NBUF - 1)) * BUF_B + wv * 1024; \
        __builtin_amdgcn_global_load_lds((const unsigned*)(kp_ + (size_t)row * kpi_ + chs * 8), (LAS unsigned*)b_, 16, 0, 0); \
        __builtin_amdgcn_global_load_lds((const unsigned*)(vp_ + (size_t)row * vpi_ + chs * 8), (LAS unsigned*)(b_ + TILE_B), 16, 0, 0); } while (0)
    asm volatile("s_waitcnt vmcnt(0)" ::: "memory");
    NSA_ISSUE2(0); if (ntiles > 1) NSA_ISSUE2(1); if (ntiles > 2) NSA_ISSUE2(2); if (ntiles > 3) NSA_ISSUE2(3);
    for (int i0 = 0; i0 < ntiles; i0 += 2) {
        if (i0 == 0) { if (ntiles > 3) asm volatile("s_waitcnt vmcnt(4)" ::: "memory"); else if (ntiles > 2) asm volatile("s_waitcnt vmcnt(2)" ::: "memory"); else asm volatile("s_waitcnt vmcnt(0)" ::: "memory"); }
        else asm volatile("s_waitcnt vmcnt(0)" ::: "memory");
        __builtin_amdgcn_s_barrier();
        asm volatile("" ::: "memory");
        if (i0 >= 2) { if (i0 + 2 < ntiles) NSA_ISSUE2(i0 + 2); if (i0 + 3 < ntiles) NSA_ISSUE2(i0 + 3); }
        LAS unsigned char* c0 = lds + (i0 & (NBUF - 1)) * BUF_B; LAS unsigned char* c1 = lds + ((i0 + 1) & (NBUF - 1)) * BUF_B;
        body(i0, (const LAS unsigned char*)c0, (const LAS unsigned char*)(c0 + TILE_B), (const LAS unsigned char*)c1, (const LAS unsigned char*)(c1 + TILE_B), i0 + 1 < ntiles);
    }
    asm volatile("s_waitcnt lgkmcnt(0)" ::: "memory");
    __builtin_amdgcn_s_barrier();
    asm volatile("" ::: "memory");
#undef NSA_ISSUE2
}
template <class Src>
__device__ __forceinline__ void stream_pre(LAS unsigned char* lds, int ntiles, int tid, Src src) {
    const int lane = tid & 63, wv = __builtin_amdgcn_readfirstlane(tid >> 6);
    const int row = 8 * wv + (lane >> 3), chs = (lane & 7) ^ ((row >> 1) & 7);
    for (int i = 0; i < 3 && i < ntiles; ++i) { const bf16* kp_; const bf16* vp_; int kpi_, vpi_; src(i, kp_, vp_, kpi_, vpi_); LAS unsigned char* b_ = lds + (i & (NBUF - 1)) * BUF_B + wv * 1024;
        __builtin_amdgcn_global_load_lds((const unsigned*)(kp_ + (size_t)row * kpi_ + chs * 8), (LAS unsigned*)b_, 16, 0, 0);
        __builtin_amdgcn_global_load_lds((const unsigned*)(vp_ + (size_t)row * vpi_ + chs * 8), (LAS unsigned*)(b_ + TILE_B), 16, 0, 0); }
}

template <int NGR>
__device__ __forceinline__ void visit2(const LAS unsigned char* Ta, const LAS unsigned char* Tb, LAS unsigned char* lds, const bf16x8 (&Q0)[NGR], const bf16x8 (&Q1)[NGR], const int (&q)[NGR], const bool (&valid)[NGR],
                                       const bool (&acta)[NGR], const bool (&actb)[NGR], bool diaga, bool diagb, int col, int fq) {
    LAS unsigned char* arow[NGR]; int sx[NGR]; LAS f32x2* mlp[NGR]; f32x2 ml[NGR]; f32x4 O[NGR][4];
#pragma unroll
    for (int gI = 0; gI < NGR; ++gI) { const int c = 4 * q[gI] + (col & 3); sx[gI] = c & 15; arow[gI] = lds + OFF_ACC + c * 256; mlp[gI] = (LAS f32x2*)(lds + OFF_ML) + c; ml[gI] = *mlp[gI];
#pragma unroll
        for (int dt = 0; dt < 4; ++dt) O[gI][dt] = *(const LAS f32x4*)(arow[gI] + (((4 * dt + fq) ^ sx[gI]) << 4)); }
    f32x4 Sa[NGR][4], Sb[NGR][4];
    const f32x4 zero4 = {0.f, 0.f, 0.f, 0.f};
    bf16x8 ka[8], kb[8];
#pragma unroll
    for (int kt = 0; kt < 4; ++kt) { ka[2 * kt] = *(const LAS bf16x8*)(Ta + swz(16 * kt + col, fq)); ka[2 * kt + 1] = *(const LAS bf16x8*)(Ta + swz(16 * kt + col, 4 + fq)); }
    __builtin_amdgcn_sched_barrier(0);
#pragma unroll
    for (int kt = 0; kt < 4; ++kt) { kb[2 * kt] = *(const LAS bf16x8*)(Tb + swz(16 * kt + col, fq)); kb[2 * kt + 1] = *(const LAS bf16x8*)(Tb + swz(16 * kt + col, 4 + fq)); }
#pragma unroll
    for (int kt = 0; kt < 4; ++kt)
#pragma unroll
        for (int gI = 0; gI < NGR; ++gI) { Sa[gI][kt] = __builtin_amdgcn_mfma_f32_16x16x32_bf16(ka[2 * kt], Q0[gI], zero4, 0, 0, 0); Sa[gI][kt] = __builtin_amdgcn_mfma_f32_16x16x32_bf16(ka[2 * kt + 1], Q1[gI], Sa[gI][kt], 0, 0, 0); }
    __builtin_amdgcn_sched_barrier(0);
#pragma unroll
    for (int kt = 0; kt < 4; ++kt)
#pragma unroll
        for (int gI = 0; gI < NGR; ++gI) { Sb[gI][kt] = __builtin_amdgcn_mfma_f32_16x16x32_bf16(kb[2 * kt], Q0[gI], zero4, 0, 0, 0); Sb[gI][kt] = __builtin_amdgcn_mfma_f32_16x16x32_bf16(kb[2 * kt + 1], Q1[gI], Sb[gI][kt], 0, 0, 0); }
    s16x4 va[16], vb[16];
    if (NGR == 1) {
#pragma unroll
        for (int dt = 0; dt < 4; ++dt)
#pragma unroll
            for (int kp = 0; kp < 2; ++kp) { const int vr0 = 32 * kp + 4 * fq + (col >> 2), vch = 2 * dt + ((col & 3) >> 1), vh = (col & 1) * 8;
                va[4 * dt + 2 * kp] = __builtin_amdgcn_ds_read_tr16_b64_v4i16((LAS s16x4*)(Ta + TILE_B + swz(vr0, vch) + vh)); va[4 * dt + 2 * kp + 1] = __builtin_amdgcn_ds_read_tr16_b64_v4i16((LAS s16x4*)(Ta + TILE_B + swz(vr0 + 16, vch) + vh)); }
#pragma unroll
        for (int dt = 0; dt < 4; ++dt)
#pragma unroll
            for (int kp = 0; kp < 2; ++kp) { const int vr0 = 32 * kp + 4 * fq + (col >> 2), vch = 2 * dt + ((col & 3) >> 1), vh = (col & 1) * 8;
                vb[4 * dt + 2 * kp] = __builtin_amdgcn_ds_read_tr16_b64_v4i16((LAS s16x4*)(Tb + TILE_B + swz(vr0, vch) + vh)); vb[4 * dt + 2 * kp + 1] = __builtin_amdgcn_ds_read_tr16_b64_v4i16((LAS s16x4*)(Tb + TILE_B + swz(vr0 + 16, vch) + vh)); }
    }
    __builtin_amdgcn_sched_barrier(0);
    bf16x8 Pa[NGR][2], Pb[NGR][2]; float alpha[NGR], mnew[NGR], lsum[NGR];
#pragma unroll
    for (int gI = 0; gI < NGR; ++gI) {
        if (diaga) {
#pragma unroll
            for (int kt = 0; kt < 4; ++kt)
#pragma unroll
                for (int j = 0; j < 4; ++j) { const int key = 16 * kt + 4 * fq + j; if (key > q[gI]) Sa[gI][kt][j] = NSA_NEG; } }
        if (diagb) {
#pragma unroll
            for (int kt = 0; kt < 4; ++kt)
#pragma unroll
                for (int j = 0; j < 4; ++j) { const int key = 16 * kt + 4 * fq + j; if (key > q[gI]) Sb[gI][kt][j] = NSA_NEG; } }
        float mxa = fmaxf(fmaxf(Sa[gI][0][0], Sa[gI][0][1]), Sa[gI][0][2]);
        mxa = fmaxf(fmaxf(mxa, Sa[gI][0][3]), Sa[gI][1][0]); mxa = fmaxf(fmaxf(mxa, Sa[gI][1][1]), Sa[gI][1][2]); mxa = fmaxf(fmaxf(mxa, Sa[gI][1][3]), Sa[gI][2][0]);
        mxa = fmaxf(fmaxf(mxa, Sa[gI][2][1]), Sa[gI][2][2]); mxa = fmaxf(fmaxf(mxa, Sa[gI][2][3]), Sa[gI][3][0]); mxa = fmaxf(fmaxf(mxa, Sa[gI][3][1]), Sa[gI][3][2]); mxa = fmaxf(mxa, Sa[gI][3][3]);
        float mxb = fmaxf(fmaxf(Sb[gI][0][0], Sb[gI][0][1]), Sb[gI][0][2]);
        mxb = fmaxf(fmaxf(mxb, Sb[gI][0][3]), Sb[gI][1][0]); mxb = fmaxf(fmaxf(mxb, Sb[gI][1][1]), Sb[gI][1][2]); mxb = fmaxf(fmaxf(mxb, Sb[gI][1][3]), Sb[gI][2][0]);
        mxb = fmaxf(fmaxf(mxb, Sb[gI][2][1]), Sb[gI][2][2]); mxb = fmaxf(fmaxf(mxb, Sb[gI][2][3]), Sb[gI][3][0]); mxb = fmaxf(fmaxf(mxb, Sb[gI][3][1]), Sb[gI][3][2]); mxb = fmaxf(mxb, Sb[gI][3][3]);
        float mx = fmaxf(acta[gI] ? mxa : NSA_NEG, actb[gI] ? mxb : NSA_NEG);
        mx = xmax16(mx); mx = xmax32(mx);
        mnew[gI] = fmaxf(ml[gI][0], mx);
        const float nba = acta[gI] ? -mnew[gI] * LOG2E : NSA_NEG, nbb = actb[gI] ? -mnew[gI] * LOG2E : NSA_NEG;
        alpha[gI] = valid[gI] ? __builtin_amdgcn_exp2f((ml[gI][0] - mnew[gI]) * LOG2E) : 0.f;
        f32x4 ls4 = (f32x4){0.f, 0.f, 0.f, 0.f};
#pragma unroll
        for (int kt = 0; kt < 4; ++kt) { f32x4 a = Sa[gI][kt] * LOG2E + nba;
            a[0] = __builtin_amdgcn_exp2f(a[0]); a[1] = __builtin_amdgcn_exp2f(a[1]); a[2] = __builtin_amdgcn_exp2f(a[2]); a[3] = __builtin_amdgcn_exp2f(a[3]);
            Sa[gI][kt] = a; ls4 = ls4 + a; }
#pragma unroll
        for (int kt = 0; kt < 4; ++kt) { f32x4 a = Sb[gI][kt] * LOG2E + nbb;
            a[0] = __builtin_amdgcn_exp2f(a[0]); a[1] = __builtin_amdgcn_exp2f(a[1]); a[2] = __builtin_amdgcn_exp2f(a[2]); a[3] = __builtin_amdgcn_exp2f(a[3]);
            Sb[gI][kt] = a; ls4 = ls4 + a; }
        lsum[gI] = xsum32(xsum16((ls4[0] + ls4[1]) + (ls4[2] + ls4[3])));
#pragma unroll
        for (int kp = 0; kp < 2; ++kp) { const f32x4 a = Sa[gI][2 * kp], c2 = Sa[gI][2 * kp + 1]; const f32x8 f = {a[0], a[1], a[2], a[3], c2[0], c2[1], c2[2], c2[3]};
            Pa[gI][kp] = __builtin_bit_cast(bf16x8, __builtin_convertvector(f, bf16x8n)); }
#pragma unroll
        for (int kp = 0; kp < 2; ++kp) { const f32x4 a = Sb[gI][2 * kp], c2 = Sb[gI][2 * kp + 1]; const f32x8 f = {a[0], a[1], a[2], a[3], c2[0], c2[1], c2[2], c2[3]};
            Pb[gI][kp] = __builtin_bit_cast(bf16x8, __builtin_convertvector(f, bf16x8n)); }
    }
    if (NGR != 1) {
#pragma unroll
        for (int dt = 0; dt < 4; ++dt)
#pragma unroll
            for (int kp = 0; kp < 2; ++kp) { const int vr0 = 32 * kp + 4 * fq + (col >> 2), vch = 2 * dt + ((col & 3) >> 1), vh = (col & 1) * 8;
                va[4 * dt + 2 * kp] = __builtin_amdgcn_ds_read_tr16_b64_v4i16((LAS s16x4*)(Ta + TILE_B + swz(vr0, vch) + vh)); va[4 * dt + 2 * kp + 1] = __builtin_amdgcn_ds_read_tr16_b64_v4i16((LAS s16x4*)(Ta + TILE_B + swz(vr0 + 16, vch) + vh)); }
#pragma unroll
        for (int dt = 0; dt < 4; ++dt)
#pragma unroll
            for (int kp = 0; kp < 2; ++kp) { const int vr0 = 32 * kp + 4 * fq + (col >> 2), vch = 2 * dt + ((col & 3) >> 1), vh = (col & 1) * 8;
                vb[4 * dt + 2 * kp] = __builtin_amdgcn_ds_read_tr16_b64_v4i16((LAS s16x4*)(Tb + TILE_B + swz(vr0, vch) + vh)); vb[4 * dt + 2 * kp + 1] = __builtin_amdgcn_ds_read_tr16_b64_v4i16((LAS s16x4*)(Tb + TILE_B + swz(vr0 + 16, vch) + vh)); }
    }
    __builtin_amdgcn_sched_barrier(0);
#pragma unroll
    for (int gI = 0; gI < NGR; ++gI)
#pragma unroll
        for (int dt = 0; dt < 4; ++dt) O[gI][dt] = O[gI][dt] * alpha[gI];
#pragma unroll
    for (int dt = 0; dt < 4; ++dt)
#pragma unroll
        for (int kp = 0; kp < 2; ++kp) { const s16x4 v0 = va[4 * dt + 2 * kp], v1 = va[4 * dt + 2 * kp + 1]; const bf16x8 vf = {v0[0], v0[1], v0[2], v0[3], v1[0], v1[1], v1[2], v1[3]};
#pragma unroll
            for (int gI = 0; gI < NGR; ++gI) O[gI][dt] = __builtin_amdgcn_mfma_f32_16x16x32_bf16(vf, Pa[gI][kp], O[gI][dt], 0, 0, 0); }
#pragma unroll
    for (int dt = 0; dt < 4; ++dt)
#pragma unroll
        for (int kp = 0; kp < 2; ++kp) { const s16x4 v0 = vb[4 * dt + 2 * kp], v1 = vb[4 * dt + 2 * kp + 1]; const bf16x8 vf = {v0[0], v0[1], v0[2], v0[3], v1[0], v1[1], v1[2], v1[3]};
#pragma unroll
            for (int gI = 0; gI < NGR; ++gI) O[gI][dt] = __builtin_amdgcn_mfma_f32_16x16x32_bf16(vf, Pb[gI][kp], O[gI][dt], 0, 0, 0); }
#pragma unroll
    for (int gI = 0; gI < NGR; ++gI)
        if (valid[gI]) {
#pragma unroll
            for (int dt = 0; dt < 4; ++dt) *(LAS f32x4*)(arow[gI] + (((4 * dt + fq) ^ sx[gI]) << 4)) = O[gI][dt];
            if (fq == 0) *mlp[gI] = (f32x2){mnew[gI], alpha[gI] * ml[gI][1] + lsum[gI]};
        }
}

__device__ __forceinline__ void attn_unit(LAS unsigned char* lds, int b, int g, int qb, const bf16* __restrict__ q, const bf16* __restrict__ cmp, const bf16* __restrict__ ks, const bf16* __restrict__ vs,
                                          const bf16* __restrict__ kw, const bf16* __restrict__ vw, const float* __restrict__ gates, bf16* __restrict__ o, float* __restrict__ gpark) {
    int tid_raw = threadIdx.x; asm volatile("" : "+v"(tid_raw));
    const int tid = tid_raw, lane = tid & 63, w = __builtin_amdgcn_readfirstlane(tid >> 6), col = lane & 15, fq = lane >> 4;
    const int bg = b * NG_ + g;
    LAS float* Gs = (LAS float*)(lds + OFF_G + w * 4096); LAS float* E3s = (LAS float*)(lds + OFF_E3 + w * 4096);
    LAS unsigned* selm = (LAS unsigned*)(lds + OFF_SEL); LAS unsigned* uni = (LAS unsigned*)(lds + OFF_UNI);
    if (tid < 4) uni[tid] = 0u;
    int tl[2]; size_t tokc[2]; bf16x8 Qf[2][2]; float gt[2][3];
#pragma unroll
    for (int cg = 0; cg < 2; ++cg) { tl[cg] = 8 * w + 4 * cg + (col >> 2); tokc[cg] = (size_t)b * S_ + 64 * qb + tl[cg];
        const bf16* qp = q + tokc[cg] * 1024 + (4 * g + (col & 3)) * 64 + 8 * fq;
        Qf[cg][0] = *(const bf16x8*)qp; Qf[cg][1] = *(const bf16x8*)(qp + 32);
        const float* gp = gates + tokc[cg] * 48 + (4 * g + (col & 3)) * 3; gt[cg][0] = gp[0]; gt[cg][1] = gp[1]; gt[cg][2] = gp[2]; }
    f32x4 Of[2][4];
    const bool both[2] = {true, true};
    float m[2], l[2], invl[2] = {0.f, 0.f}; f32x4 O[2][4];
    {
        const int ncb = (4 * qb + 3 + 63) >> 6;
        const bf16* cbase = cmp + (size_t)bg * NCMP_ * 256;
        int lim[2];
#pragma unroll
        for (int cg = 0; cg < 2; ++cg) { const int t = 64 * qb + tl[cg]; lim[cg] = (t >= 31) ? ((t - 31) >> 4) : -1; m[cg] = NSA_NEG; l[cg] = 0.f; }
        auto src = [&](int i, const bf16*& kp, const bf16*& vp, int& kpi, int& vpi) { kp = cbase + (size_t)(64 * i) * 256; vp = kp + 64; kpi = 256; vpi = 256; };
        stream2(lds, ncb, tid, src, [&](int i0, const LAS unsigned char* K0, const LAS unsigned char* V0, const LAS unsigned char* K1, const LAS unsigned char* V1, bool two) {
            if (two && 64 * (i0 + 1) + 65 <= 4 * qb) { visitw<1>(K0, V0, K1, V1, Qf, m, l, O, invl, Gs, E3s, 0, 0, col, fq); return; }
            for (int i = i0; i < i0 + (two ? 2 : 1); ++i) { const LAS unsigned char* Kt = (i == i0) ? K0 : K1; const LAS unsigned char* Vt = (i == i0) ? V0 : V1;
                const int klo[2] = {0, 0}; const int khi[2] = {lim[0] - 64 * i, lim[1] - 64 * i};
                if (64 * i + 65 > 4 * qb) visit<1, true>(Kt, Vt, both, both, Qf, klo, khi, m, l, O, invl, Gs, E3s, 0, col, fq);
                else visit<1, false>(Kt, Vt, both, both, Qf, klo, khi, m, l, O, invl, Gs, E3s, 0, col, fq); } });
#pragma unroll
        for (int cg = 0; cg < 2; ++cg) { float lt = xsum32(xsum16(l[cg])); invl[cg] = 1.0f / fmaxf(lt, 1e-30f);
#pragma unroll
            for (int dt = 0; dt < 4; ++dt) O[cg][dt] = (f32x4){0.f, 0.f, 0.f, 0.f}; }
        stream2(lds, ncb, tid, src, [&](int i0, const LAS unsigned char* K0, const LAS unsigned char* V0, const LAS unsigned char* K1, const LAS unsigned char* V1, bool two) {
            if (two && 64 * (i0 + 1) + 65 <= 4 * qb) { visitw<2>(K0, V0, K1, V1, Qf, m, l, O, invl, Gs, E3s, 16 * i0, 16 * i0 + 16, col, fq); return; }
            for (int i = i0; i < i0 + (two ? 2 : 1); ++i) { const LAS unsigned char* Kt = (i == i0) ? K0 : K1; const LAS unsigned char* Vt = (i == i0) ? V0 : V1;
                const int klo[2] = {0, 0}; const int khi[2] = {lim[0] - 64 * i, lim[1] - 64 * i};
                if (64 * i + 65 > 4 * qb) visit<2, true>(Kt, Vt, both, both, Qf, klo, khi, m, l, O, invl, Gs, E3s, 16 * i, col, fq);
                else visit<2, false>(Kt, Vt, both, both, Qf, klo, khi, m, l, O, invl, Gs, E3s, 16 * i, col, fq); } });
#pragma unroll
        for (int cg = 0; cg < 2; ++cg)
#pragma unroll
            for (int dt = 0; dt < 4; ++dt) Of[cg][dt] = O[cg][dt] * gt[cg][0];
    }
    f32x4* gp4 = (f32x4*)gpark + w * 512 + lane;
#pragma unroll
    for (int cg = 0; cg < 2; ++cg)
#pragma unroll
        for (int dt = 0; dt < 4; ++dt) gp4[(cg * 4 + dt) * 64] = Of[cg][dt];
    const bf16* kbf = ks + (size_t)bg * S_ * 64; const bf16* vbf = vs + (size_t)bg * S_ * 64;
    const bool dmode = qb < SEL_DENSE_QB;
    auto srcf = [&](int i, const bf16*& kp, const bf16*& vp, int& kpi, int& vpi) { const int n = dmode ? i : (i == 0 ? 0 : qb - 2 + i); kp = kbf + (size_t)n * 4096; vp = vbf + (size_t)n * 4096; kpi = 64; vpi = 64; };
    stream_pre(lds, dmode ? qb + 1 : 3, tid, srcf);
    asm volatile("s_waitcnt lgkmcnt(0)" ::: "memory"); __builtin_amdgcn_wave_barrier();
    {
        unsigned long long mk0[8], mk1[8];
        if (qb < 16) {
#pragma unroll
            for (int q8 = 0; q8 < 8; ++q8) { mk0[q8] = 0ull; mk1[q8] = 0ull; }
        } else {
            const int n0 = lane, n1 = lane + 64, hi = qb - 2;
            const bool c0 = (n0 >= 1 && n0 <= hi), c1 = (n1 <= hi);
            unsigned v0[8], v1[8], thr[8];
#pragma unroll
            for (int q8 = 0; q8 < 8; ++q8) { const float imp0 = Gs[q8 * 128 + n0] + (n0 > 0 ? E3s[q8 * 128 + n0 - 1] : 0.f), imp1 = Gs[q8 * 128 + n1] + E3s[q8 * 128 + n1 - 1];
                v0[q8] = c0 ? (__float_as_uint(imp0) >> 16) : 0u; v1[q8] = c1 ? (__float_as_uint(imp1) >> 16) : 0u; thr[q8] = 0u; }
            for (int bit = 14; bit >= 0; --bit) {
#pragma unroll
                for (int q8 = 0; q8 < 8; ++q8) { const unsigned tst = thr[q8] | (1u << bit);
                    const int cnt = __builtin_popcountll(__ballot(c0 && v0[q8] >= tst)) + __builtin_popcountll(__ballot(c1 && v1[q8] >= tst));
                    if (cnt >= 13) thr[q8] = tst; } }
            const unsigned long long below = (1ull << lane) - 1ull;
#pragma unroll
            for (int q8 = 0; q8 < 8; ++q8) {
                const unsigned long long g0 = __ballot(c0 && v0[q8] > thr[q8]), g1 = __ballot(c1 && v1[q8] > thr[q8]), e0 = __ballot(c0 && v0[q8] == thr[q8]), e1 = __ballot(c1 && v1[q8] == thr[q8]);
                const int need = 13 - (__builtin_popcountll(g0) + __builtin_popcountll(g1));
                const bool t0 = c0 && v0[q8] == thr[q8] && __builtin_popcountll(e0 & below) < need, t1 = c1 && v1[q8] == thr[q8] && (__builtin_popcountll(e0) + __builtin_popcountll(e1 & below)) < need;
                const bool s0 = (c0 && v0[q8] > thr[q8]) || t0, s1 = (c1 && v1[q8] > thr[q8]) || t1;
                mk0[q8] = __ballot(s0); mk1[q8] = __ballot(s1); }
        }
        unsigned long long um0 = 0ull, um1 = 0ull;
#pragma unroll
        for (int q8 = 0; q8 < 8; ++q8) { um0 |= mk0[q8]; um1 |= mk1[q8];
            if (lane == 0) { LAS unsigned* sp = selm + (8 * w + q8) * 4; sp[0] = (unsigned)mk0[q8]; sp[1] = (unsigned)(mk0[q8] >> 32); sp[2] = (unsigned)mk1[q8]; sp[3] = (unsigned)(mk1[q8] >> 32); } }
        if (lane == 0 && !dmode) { __hip_atomic_fetch_or(uni + 0, (unsigned)um0, __ATOMIC_RELAXED, __HIP_MEMORY_SCOPE_WORKGROUP); __hip_atomic_fetch_or(uni + 1, (unsigned)(um0 >> 32), __ATOMIC_RELAXED, __HIP_MEMORY_SCOPE_WORKGROUP);
            __hip_atomic_fetch_or(uni + 2, (unsigned)um1, __ATOMIC_RELAXED, __HIP_MEMORY_SCOPE_WORKGROUP); __hip_atomic_fetch_or(uni + 3, (unsigned)(um1 >> 32), __ATOMIC_RELAXED, __HIP_MEMORY_SCOPE_WORKGROUP); }
    }
    __syncthreads();
    {
        const int ntf = dmode ? qb + 1 : 3;
#pragma unroll
        for (int cg = 0; cg < 2; ++cg) { m[cg] = NSA_NEG; l[cg] = 0.f;
#pragma unroll
            for (int dt = 0; dt < 4; ++dt) O[cg][dt] = (f32x4){0.f, 0.f, 0.f, 0.f}; }
        if (!dmode) {
            asm volatile("s_waitcnt vmcnt(0)" ::: "memory"); __builtin_amdgcn_s_barrier(); asm volatile("" ::: "memory");
            const int klo[2] = {0, 0}; const int khi[2] = {tl[0], tl[1]};
            visitw<0>(lds, lds + TILE_B, lds + BUF_B, lds + BUF_B + TILE_B, Qf, m, l, O, invl, Gs, E3s, 0, 0, col, fq);
            visit<0, true>(lds + 2 * BUF_B, lds + 2 * BUF_B + TILE_B, both, both, Qf, klo, khi, m, l, O, invl, Gs, E3s, 0, col, fq);
            asm volatile("s_waitcnt lgkmcnt(0)" ::: "memory"); __builtin_amdgcn_s_barrier(); asm volatile("" ::: "memory");
        } else
        stream(lds, ntf, tid, srcf, [&](int i, const LAS unsigned char* Kt, const LAS unsigned char* Vt) {
            const int n = dmode ? i : (i == 0 ? 0 : qb - 2 + i); const int klo[2] = {0, 0}; const int khi[2] = {tl[0], tl[1]};
            bool on[2] = {true, true};
            if (qb >= 16 && n >= 1 && n < qb - 1) {
#pragma unroll
                for (int cg = 0; cg < 2; ++cg) on[cg] = ((selm[tl[cg] * 4 + (n >> 5)] >> (n & 31)) & 1u) != 0u; }
            if (n == qb) visit<0, true>(Kt, Vt, both, both, Qf, klo, khi, m, l, O, invl, Gs, E3s, 0, col, fq); else visit<0, false>(Kt, Vt, both, on, Qf, klo, khi, m, l, O, invl, Gs, E3s, 0, col, fq); }, true);
    }
    {
        const unsigned u0 = uni[0], u1 = uni[1], u2 = uni[2], u3 = uni[3];
        const unsigned long long um0 = ((unsigned long long)(unsigned)__builtin_amdgcn_readfirstlane((int)u1) << 32) | (unsigned)__builtin_amdgcn_readfirstlane((int)u0),
                                 um1 = ((unsigned long long)(unsigned)__builtin_amdgcn_readfirstlane((int)u3) << 32) | (unsigned)__builtin_amdgcn_readfirstlane((int)u2);
        const int nsel = __builtin_popcountll(um0) + __builtin_popcountll(um1), nsteps = (nsel + 1) >> 1;
        LAS unsigned* AM = (LAS unsigned*)(lds + OFF_AM); LAS unsigned char* QL = lds + OFF_QL; LAS unsigned* QC = (LAS unsigned*)(lds + OFF_QC); LAS unsigned char* TL = lds + OFF_TL;
        const unsigned long long below = (1ull << lane) - 1ull;
        {
            const unsigned sw = selm[lane * 4 + (w >> 1)] >> (16 * (w & 1));
#pragma unroll
            for (int j = 0; j < 16; ++j) { const unsigned long long bm = __ballot(((sw >> j) & 1u) != 0u); if (lane == 0) { AM[2 * (16 * w + j)] = (unsigned)bm; AM[2 * (16 * w + j) + 1] = (unsigned)(bm >> 32); } }
#pragma unroll
            for (int cg = 0; cg < 2; ++cg) { const int c = 4 * tl[cg] + (col & 3); const float lt = xsum32(xsum16(l[cg]));
#pragma unroll
                for (int dt = 0; dt < 4; ++dt) *(LAS f32x4*)(lds + OFF_ACC + c * 256 + (((4 * dt + fq) ^ (c & 15)) << 4)) = O[cg][dt];
                if (fq == 0) ((LAS f32x2*)(lds + OFF_ML))[c] = (f32x2){m[cg], lt}; }
            if ((um0 >> lane) & 1ull) TL[__builtin_popcountll(um0 & below)] = (unsigned char)lane;
            if ((um1 >> lane) & 1ull) TL[__builtin_popcountll(um0) + __builtin_popcountll(um1 & below)] = (unsigned char)(64 + lane);
        }
        __syncthreads();
        for (int s = w; s < nsteps; s += 8) {
            const int na = TL[2 * s], nb2 = (2 * s + 1 < nsel) ? TL[2 * s + 1] : na;
            const unsigned long long am = ((unsigned long long)(AM[2 * na + 1] | AM[2 * nb2 + 1]) << 32) | (unsigned long long)(AM[2 * na] | AM[2 * nb2]);
            if ((am >> lane) & 1ull) QL[s * 64 + __builtin_popcountll(am & below)] = (unsigned char)lane;
            if (lane == 0) { const unsigned cnt = (unsigned)__builtin_popcountll(am); const bool hb = 2 * s + 1 < nsel; QC[s] = cnt;
                LAS unsigned* rec = (LAS unsigned*)(lds + OFF_REC) + 8 * s;
                rec[0] = AM[2 * na]; rec[1] = AM[2 * na + 1]; rec[2] = hb ? AM[2 * nb2] : 0u; rec[3] = hb ? AM[2 * nb2 + 1] : 0u; rec[4] = (unsigned)na | ((unsigned)nb2 << 8) | (cnt << 16) | (hb ? (1u << 24) : 0u); }
        }
        __syncthreads();
        const bf16* kb = ks + (size_t)bg * S_ * 64; const bf16* vb = vs + (size_t)bg * S_ * 64;
        const int drow = 8 * w + (lane >> 3), dchs = (lane & 7) ^ ((drow >> 1) & 7);
        const LAS unsigned* REC = (const LAS unsigned*)(lds + OFF_REC);
        auto issue = [&](int s, unsigned info) {
            const int na = __builtin_amdgcn_readfirstlane((int)(info & 0xffu)), nb2 = __builtin_amdgcn_readfirstlane((int)((info >> 8) & 0xffu));
            LAS unsigned char* base = lds + (s & 1) * 2 * BUF_B + w * 1024;
            __builtin_amdgcn_global_load_lds((const unsigned*)(kb + (size_t)na * 4096 + drow * 64 + dchs * 8), (LAS unsigned*)base, 16, 0, 0);
            __builtin_amdgcn_global_load_lds((const unsigned*)(vb + (size_t)na * 4096 + drow * 64 + dchs * 8), (LAS unsigned*)(base + TILE_B), 16, 0, 0);
            __builtin_amdgcn_global_load_lds((const unsigned*)(kb + (size_t)nb2 * 4096 + drow * 64 + dchs * 8), (LAS unsigned*)(base + BUF_B), 16, 0, 0);
            __builtin_amdgcn_global_load_lds((const unsigned*)(vb + (size_t)nb2 * 4096 + drow * 64 + dchs * 8), (LAS unsigned*)(base + BUF_B + TILE_B), 16, 0, 0); };
        auto lookup = [&](int s, int gi, int& qv, bool& vl) { const int cnt = (int)QC[s]; const int rank = 4 * gi + (col >> 2); vl = rank < cnt; qv = vl ? (int)QL[s * 64 + rank] : 0; };
        auto qload = [&](int qv, bf16x8& A, bf16x8& B) { const bf16* qp = q + ((size_t)b * S_ + 64 * qb + qv) * 1024 + (4 * g + (col & 3)) * 64 + 8 * fq; A = *(const bf16x8*)qp; B = *(const bf16x8*)(qp + 32); };
        if (nsteps > 0) {
        const int rk = 4 * w + (col >> 2);
        u32x4 mkc = *(const LAS u32x4*)(REC), mkn; unsigned infc = REC[4], infn; int qin;
        int qn0 = (int)QL[rk]; bool vn0 = rk < (int)((infc >> 16) & 0xffu); qn0 = vn0 ? qn0 : 0;
        bf16x8 QnA0, QnB0;
        asm volatile("s_waitcnt vmcnt(0)" ::: "memory");
        qload(qn0, QnA0, QnB0);
        issue(0, infc);
        { const int s1 = nsteps > 1 ? 1 : 0; mkn = *(const LAS u32x4*)(REC + 8 * s1); infn = REC[8 * s1 + 4]; qin = (int)QL[s1 * 64 + rk]; }
        for (int s = 0; s < nsteps; ++s) {
            asm volatile("s_waitcnt vmcnt(0) lgkmcnt(0)" ::: "memory");
            __builtin_amdgcn_s_barrier();
            asm volatile("" ::: "memory");
            const int qc0 = qn0; const bool vc0 = vn0; const bf16x8 QA0 = QnA0, QB0 = QnB0;
            if (s + 1 < nsteps) { vn0 = rk < (int)((infn >> 16) & 0xffu); qn0 = vn0 ? qin : 0; qload(qn0, QnA0, QnB0); issue(s + 1, infn); }
            const unsigned long long ama = ((unsigned long long)(unsigned)__builtin_amdgcn_readfirstlane((int)mkc.y) << 32) | (unsigned)__builtin_amdgcn_readfirstlane((int)mkc.x);
            const unsigned long long amb = ((unsigned long long)(unsigned)__builtin_amdgcn_readfirstlane((int)mkc.w) << 32) | (unsigned)__builtin_amdgcn_readfirstlane((int)mkc.z);
            const unsigned infu = (unsigned)__builtin_amdgcn_readfirstlane((int)infc);
            const int na = (int)(infu & 0xffu), nb2 = (int)((infu >> 8) & 0xffu), cnt = (int)((infu >> 16) & 0xffu); const bool has_b = (infu >> 24) != 0u;
            const LAS unsigned char* Ta = lds + (s & 1) * 2 * BUF_B; const LAS unsigned char* Tb = Ta + BUF_B;
            if (4 * (w + 8) < cnt) {
                int qv1; bool vl1; bf16x8 QA1, QB1; lookup(s, w + 8, qv1, vl1); qload(qv1, QA1, QB1);
                const bf16x8 Q0g[2] = {QA0, QA1}, Q1g[2] = {QB0, QB1}; const int qg[2] = {qc0, qv1}; const bool vg[2] = {vc0, vl1};
                const bool aa[2] = {vc0 && ((ama >> qc0) & 1ull) != 0ull, vl1 && ((ama >> qv1) & 1ull) != 0ull}, ab[2] = {vc0 && ((amb >> qc0) & 1ull) != 0ull, vl1 && ((amb >> qv1) & 1ull) != 0ull};
                visit2<2>(Ta, Tb, lds, Q0g, Q1g, qg, vg, aa, ab, na == qb, has_b && nb2 == qb, col, fq);
            } else if (4 * w < cnt) {
                const bf16x8 Q0g[1] = {QA0}, Q1g[1] = {QB0}; const int qg[1] = {qc0}; const bool vg[1] = {vc0};
                const bool aa[1] = {vc0 && ((ama >> qc0) & 1ull) != 0ull}, ab[1] = {vc0 && ((amb >> qc0) & 1ull) != 0ull};
                visit2<1>(Ta, Tb, lds, Q0g, Q1g, qg, vg, aa, ab, na == qb, has_b && nb2 == qb, col, fq);
            }
            mkc = mkn; infc = infn;
            { const int s2 = s + 2 < nsteps ? s + 2 : nsteps - 1; mkn = *(const LAS u32x4*)(REC + 8 * s2); infn = REC[8 * s2 + 4]; qin = (int)QL[s2 * 64 + rk]; }
        }
        }
        asm volatile("s_waitcnt lgkmcnt(0)" ::: "memory");
        __builtin_amdgcn_s_barrier();
        asm volatile("" ::: "memory");
        asm volatile("" : "+v"(tl[0]), "+v"(tl[1]));
#pragma unroll
        for (int cg = 0; cg < 2; ++cg) tokc[cg] = (size_t)b * S_ + 64 * qb + tl[cg];
        int lane_o = lane; asm volatile("" : "+v"(lane_o));
        const f32x4* gp4o = (const f32x4*)gpark + w * 512 + lane_o;
#pragma unroll
        for (int cg = 0; cg < 2; ++cg) { const bf16* qp = q + tokc[cg] * 1024 + (4 * g + (col & 3)) * 64 + 8 * fq; Qf[cg][0] = *(const bf16x8*)qp; Qf[cg][1] = *(const bf16x8*)(qp + 32);
            const float* gp = gates + tokc[cg] * 48 + (4 * g + (col & 3)) * 3; gt[cg][1] = gp[1]; gt[cg][2] = gp[2]; }
#pragma unroll
        for (int cg = 0; cg < 2; ++cg) { const int c = 4 * tl[cg] + (col & 3); const f32x2 ml = ((const LAS f32x2*)(lds + OFF_ML))[c]; const float sc = gt[cg][1] / fmaxf(ml[1], 1e-30f);
#pragma unroll
            for (int dt = 0; dt < 4; ++dt) Of[cg][dt] = gp4o[(cg * 4 + dt) * 64] + *(const LAS f32x4*)(lds + OFF_ACC + c * 256 + (((4 * dt + fq) ^ (c & 15)) << 4)) * sc; }
        __syncthreads();
    }
    LAS f32x4* park = (LAS f32x4*)(lds + OFF_G + w * 8192) + lane;
#pragma unroll
    for (int cg = 0; cg < 2; ++cg)
#pragma unroll
        for (int dt = 0; dt < 4; ++dt) park[(cg * 4 + dt) * 64] = Of[cg][dt];
    {
        const int nb0 = qb >= 8 ? qb - 8 : 0, nwin = qb - nb0 + 1;
#pragma unroll
        for (int cg = 0; cg < 2; ++cg) { m[cg] = NSA_NEG; l[cg] = 0.f;
#pragma unroll
            for (int dt = 0; dt < 4; ++dt) O[cg][dt] = (f32x4){0.f, 0.f, 0.f, 0.f}; }
        const bf16* kb = kw + (size_t)bg * S_ * 64; const bf16* vb = vw + (size_t)bg * S_ * 64;
        auto src = [&](int i, const bf16*& kp, const bf16*& vp, int& kpi, int& vpi) { kp = kb + (size_t)(nb0 + i) * 64 * 64; vp = vb + (size_t)(nb0 + i) * 64 * 64; kpi = 64; vpi = 64; };
        stream2(lds, nwin, tid, src, [&](int i0, const LAS unsigned char* K0, const LAS unsigned char* V0, const LAS unsigned char* K1, const LAS unsigned char* V1, bool two) {
            { const int n0 = nb0 + i0; if (two && n0 != qb - 8 && n0 + 1 != qb) { visitw<0>(K0, V0, K1, V1, Qf, m, l, O, invl, Gs, E3s, 0, 0, col, fq); return; } }
            for (int i = i0; i < i0 + (two ? 2 : 1); ++i) { const LAS unsigned char* Kt = (i == i0) ? K0 : K1; const LAS unsigned char* Vt = (i == i0) ? V0 : V1;
                const int n = nb0 + i; int klo[2], khi[2];
#pragma unroll
                for (int cg = 0; cg < 2; ++cg) { klo[cg] = (n == qb - 8) ? tl[cg] + 1 : 0; khi[cg] = (n == qb) ? tl[cg] : 63; }
                if (n == qb || n == qb - 8) visit<0, true>(Kt, Vt, both, both, Qf, klo, khi, m, l, O, invl, Gs, E3s, 0, col, fq); else visit<0, false>(Kt, Vt, both, both, Qf, klo, khi, m, l, O, invl, Gs, E3s, 0, col, fq); } });
#pragma unroll
        for (int cg = 0; cg < 2; ++cg) { float lt = xsum32(xsum16(l[cg])); const float sc = gt[cg][2] / fmaxf(lt, 1e-30f);
#pragma unroll
            for (int dt = 0; dt < 4; ++dt) O[cg][dt] = park[(cg * 4 + dt) * 64] + O[cg][dt] * sc; }
    }
#pragma unroll
    for (int cg = 0; cg < 2; ++cg) { bf16* op = o + tokc[cg] * 1024 + (4 * g + (col & 3)) * 64 + 4 * fq;
#pragma unroll
        for (int dt = 0; dt < 4; ++dt) { uint2 wv; wv.x = pk_bf16(O[cg][dt][0], O[cg][dt][1]); wv.y = pk_bf16(O[cg][dt][2], O[cg][dt][3]); *(uint2*)(op + 16 * dt) = wv; } }
}
__device__ __forceinline__ void attn_phase(LAS unsigned char* lds, const bf16* __restrict__ q, const bf16* __restrict__ cmp, const bf16* __restrict__ ks, const bf16* __restrict__ vs, const bf16* __restrict__ kw,
                                           const bf16* __restrict__ vw, const float* __restrict__ gates, bf16* __restrict__ o, float* __restrict__ gpark, int G, int bid) {
    const int nunit = NB_ * NG_ * (S_ / 64);
    for (int i = 0, L = bid; L < nunit; ++i, L += G) {
        const int Lc = ((i & 1) && (nunit % G) == 0) ? (L - bid) + (G - 1 - bid) : L;
        const int qb = (S_ / 64) - 1 - Lc / 16, bg = Lc & 15;
        attn_unit(lds, bg >> 2, bg & 3, qb, q, cmp, ks, vs, kw, vw, gates, o, gpark + (size_t)bid * 16384);
        __syncthreads();
    }
}
}
#define XB_TMO      128
#define XB_XCNT(j)  (256  + 64 * (j))
#define XB_XSUB(j)  (1280 + 64 * (j))
#define XB_XGEN(j)  (2304 + 64 * (j))
#define XB_TOP      3328
#define XB_TOPGEN   3392
#define XCD_BAR_WORDS 3456
#define XB_SPIN_CAP (1u << 18)

__device__ __forceinline__ unsigned xb_ld(unsigned* p)              { return __hip_atomic_load(p, __ATOMIC_RELAXED, __HIP_MEMORY_SCOPE_AGENT); }
__device__ __forceinline__ unsigned xb_add(unsigned* p, unsigned v) { return __hip_atomic_fetch_add(p, v, __ATOMIC_RELAXED, __HIP_MEMORY_SCOPE_AGENT); }
__device__ __forceinline__ unsigned xb_xcc_id() { return (unsigned)__builtin_amdgcn_s_getreg((3 << 11) | 20) & 0xFu; }
#define XB_SPIN(cond, bar) do { unsigned _sp = 0; while (cond) { __builtin_amdgcn_s_sleep(1); \
    if ((++_sp & 255u) == 0u) { if (xb_ld(&(bar)[XB_TMO])) break; if (_sp > XB_SPIN_CAP) { atomicAdd(&(bar)[XB_TMO], 1u); break; } } } } while (0)

struct XcdBarrier {
    unsigned* bar; unsigned x;
    volatile LAS unsigned* st;
};

__device__ __forceinline__ XcdBarrier xcd_barrier_post(unsigned* bar, volatile LAS unsigned* st) {
    XcdBarrier b; b.bar = bar; b.x = xb_xcc_id(); b.st = st;
    if (threadIdx.x == 0) (void)xb_add(&bar[XB_XCNT(b.x)], 1u);
    return b;
}
__device__ __forceinline__ void xcd_barrier_complete(unsigned* bar, unsigned x, unsigned& nloc, unsigned& nx) {
    const unsigned G = gridDim.x * gridDim.y * gridDim.z;
    unsigned sum, cnt, mine, sp = 0u;
    for (;;) {
        sum = 0u; cnt = 0u; mine = 0u;
#pragma unroll
        for (unsigned j = 0; j < 16; ++j) { const unsigned c = xb_ld(&bar[XB_XCNT(j)]); sum += c; cnt += (c > 0u) ? 1u : 0u; mine = (j == x) ? c : mine; }
        if (sum == G) break;
        __builtin_amdgcn_s_sleep(1);
        if ((++sp & 255u) == 0u) { if (xb_ld(&bar[XB_TMO])) break; if (sp > XB_SPIN_CAP) { atomicAdd(&bar[XB_TMO], 1u); break; } }
    }
    nloc = mine > 0u ? mine : 1u; nx = cnt > 0u ? cnt : 1u;
}

__device__ __forceinline__ void xcd_barrier(const XcdBarrier& b) {
    asm volatile("s_waitcnt vmcnt(0)" ::: "memory");
    __syncthreads();
    if (threadIdx.x == 0) {
        unsigned* bar = b.bar;
        __builtin_amdgcn_s_waitcnt(0);
        unsigned nloc = b.st[0], nx = b.st[1];
        if (nloc == 0u) { xcd_barrier_complete(bar, b.x, nloc, nx); b.st[0] = nloc; b.st[1] = nx; }
        const unsigned old = xb_add(&bar[XB_XSUB(b.x)], 1u);
        const unsigned gen = old / nloc;
        if (old + 1u == (gen + 1u) * nloc) {
            __builtin_amdgcn_fence(__ATOMIC_RELEASE, "agent");
            asm volatile("s_waitcnt vmcnt(0)" ::: "memory");
            const unsigned og = xb_add(&bar[XB_TOP], 1u);
            const unsigned tg = og / nx;
            if (og + 1u == (tg + 1u) * nx) xb_add(&bar[XB_TOPGEN], 1u);
            else XB_SPIN(xb_ld(&bar[XB_TOPGEN]) == tg, bar);
            __builtin_amdgcn_fence(__ATOMIC_ACQUIRE, "agent");
            xb_add(&bar[XB_XGEN(b.x)], 1u);
            asm volatile("s_waitcnt vmcnt(0)" ::: "memory");
        } else {
            XB_SPIN(xb_ld(&bar[XB_XGEN(b.x)]) == gen, bar);
            __builtin_amdgcn_fence(__ATOMIC_ACQUIRE, "agent");
            asm volatile("s_waitcnt vmcnt(0)" ::: "memory");
        }
    }
    __syncthreads();
}


constexpr size_t MiB = (size_t)1 << 20;
constexpr size_t O_WLIN = 0, O_WLOUT = 6 * MiB, O_WFGU = 9 * MiB, O_WFD = 23 * MiB, O_WNIN = 30 * MiB, O_WNOUT = 36 * MiB, O_WC1K = 38 * MiB, O_WC1V = 39 * MiB, O_WC2 = 40 * MiB,
                 O_WMGU = 41 * MiB, O_WMD = 55 * MiB, O_TAB = 62 * MiB;
constexpr size_t O_HB = 64 * MiB, O_BIG = 128 * MiB, O_Y = 352 * MiB;
constexpr size_t O_Q = 352 * MiB, O_KC = 416 * MiB, O_VC = 432 * MiB, O_KS = 448 * MiB, O_VS = 464 * MiB, O_KW = 480 * MiB, O_VW = 496 * MiB, O_HC = 513 * MiB, O_CMP = 521 * MiB;
constexpr size_t O_RG = 525 * MiB, O_NG = 526 * MiB, O_BIAS1 = 532 * MiB, O_CTL = 533 * MiB, CTL_BYTES = 64 * 1024, O_RSQ = 534 * MiB  , WS_NEED = 538 * MiB;
constexpr size_t O_MW = 128 * MiB, MW_STRIDE = 21 * MiB, O_HID = 275 * MiB, HID_ELEMS = (size_t)72 * 256 * FF_, O_IDX = 21 * MiB, O_WROW = 23 * MiB; constexpr int MCAP = 32768;
constexpr float MOE_SA = 16.0f, MOE_SW = 512.0f, MOE_SH = 8.0f, MOE_SWD = 1024.0f;
constexpr int LDS_BYTES = 163840, MISC_OFF = 159744;

struct Params { const float* in[27]; float* out; unsigned char* ws; };
__device__ __forceinline__ void* karg(int i) {
    const __attribute__((address_space(4))) unsigned char* ka = (const __attribute__((address_space(4))) unsigned char*)__builtin_amdgcn_kernarg_segment_ptr();
    int off = i * 8; asm volatile("" : "+s"(off));
    return *(void* const __attribute__((address_space(4)))*)(ka + off);
}

__global__ void __launch_bounds__(NTHR, 2) mega(Params p) {
    extern __shared__ __attribute__((aligned(16))) unsigned char lds_raw[];
    LAS unsigned char* lds = (LAS unsigned char*)lds_raw;
    const int tid = otid(), G = (int)gridDim.x, bid = (int)blockIdx.x;
    volatile LAS unsigned* MISC = (volatile LAS unsigned*)(lds + MISC_OFF);
    if (tid < 16) MISC[tid] = 0u;
    __syncthreads();
    XcdBarrier bar = xcd_barrier_post((unsigned*)((unsigned char*)karg(28) + O_CTL), MISC);
#define IN(i) ((const float*)karg(i))
#define x IN(0)
#define norm_mix IN(1)
#define norm_ffn IN(2)
#define norm_final IN(3)
#define lru_w_in IN(4)
#define lru_b_in IN(5)
#define conv_w IN(6)
#define conv_b IN(7)
#define w_a IN(8)
#define b_a IN(9)
#define w_i IN(10)
#define b_i IN(11)
#define lam IN(12)
#define lru_w_out IN(13)
#define lru_b_out IN(14)
#define nsa_w_in IN(15)
#define cmp_pe IN(16)
#define cmp_w1 IN(17)
#define cmp_w2 IN(18)
#define nsa_w_out IN(19)
#define ffn_wg IN(20)
#define ffn_wu IN(21)
#define ffn_wd IN(22)
#define w_router IN(23)
#define moe_wg IN(24)
#define moe_wu IN(25)
#define moe_wd IN(26)
#define WSB(off) ((bf16*)((unsigned char*)karg(28) + (off)))
#define WLIN WSB(O_WLIN)
#define WLOUT WSB(O_WLOUT)
#define WFGU WSB(O_WFGU)
#define WFD WSB(O_WFD)
#define WNIN WSB(O_WNIN)
#define WNOUT WSB(O_WNOUT)
#define WC1K WSB(O_WC1K)
#define WC1V WSB(O_WC1V)
#define WC2 WSB(O_WC2)
#define WMGU WSB(O_WMGU)
#define WMD WSB(O_WMD)
#define TAB ((float2*)((unsigned char*)karg(28) + O_TAB))
#define HB ((bf16*)karg(27))
#define SB WSB(O_HB)
#define BIG WSB(O_BIG)
#define Y WSB(O_Y)
#define Q WSB(O_Q)
#define KC WSB(O_KC)
#define VC WSB(O_VC)
#define KS WSB(O_KS)
#define VS WSB(O_VS)
#define KW WSB(O_KW)
#define VW WSB(O_VW)
#define HC WSB(O_HC)
#define CMP WSB(O_CMP)
#define RG ((float*)((unsigned char*)karg(28) + O_RG))
#define NGT ((float*)((unsigned char*)karg(28) + O_NG))
#define BIAS1 ((float*)((unsigned char*)karg(28) + O_BIAS1))
#define out ((float*)karg(27))
#define MCNT ((int*)((unsigned char*)karg(28) + O_CTL + 32768))
#define RS0 ((float*)((unsigned char*)karg(28) + O_RSQ + 3 * MiB))
#define RSQ1 ((float*)((unsigned char*)karg(28) + O_RSQ))
#define RSQ2 ((float*)((unsigned char*)karg(28) + O_RSQ + 2 * MiB))
#define MIDX ((int*)((unsigned char*)karg(28) + O_IDX))
#define MWROW ((float*)((unsigned char*)karg(28) + O_WROW))
    const int BIGN = 1 << 30;
    LAS float* scr = (LAS float*)lds;
#define GRID_BAR() xcd_barrier(bar)
#define MOE_FUSED(e0_, e1_, G_, b_) moe_conv_fused(scr, moe_wg, moe_wu, moe_wd, (unsigned char*)karg(28), O_MW, MW_STRIDE, (e0_), (e1_), (G_), (b_), MOE_SW, MOE_SWD)
#define MOE_CONV(e_, G_, b_) do { bf16* wgu_ = ((e_) == 7) ? WSB(0) : WSB(O_MW + (size_t)(e_) * MW_STRIDE); bf16* wd_ = (bf16*)((unsigned char*)wgu_ + (size_t)2 * FF_ * D_); \
        convT_job<true>(scr, moe_wg + (size_t)(e_) * D_ * FF_, wgu_, D_, FF_, FF_, D_, 0, 128, 256, 0, (G_), (b_), MOE_SW); convT_job<true>(scr, moe_wu + (size_t)(e_) * D_ * FF_, wgu_, D_, FF_, FF_, D_, 0, 128, 256, 128, (G_), (b_), MOE_SW); \
        convT_job<true>(scr, moe_wd + (size_t)(e_) * FF_ * D_, wd_, FF_, D_, D_, FF_, 0, BIGN, 0, 0, (G_), (b_), MOE_SWD); } while (0)
#define GEMM(EPI, Aptr, Bptr, M_, N_, K_, LDA_, LDB_, E_) do { pg8::Gemm g_; g_.A = (Aptr); g_.Bt = (Bptr); g_.M = (M_); g_.N = (N_); g_.K = (K_); g_.lda = (LDA_); g_.ldb = (LDB_); g_.pad = 0; \
        pg8::StaticOrder S_o; S_o.init((M_), (N_), G, bid); pg8::gemm_phase<EPI, pg8::StaticOrder, true, true>(lds, g_, S_o, (E_)); } while (0)

    convT_job(scr, lru_w_in, WLIN, D_, 2 * DR_, 2 * DR_, D_, 0, BIGN, 0, 0, G, bid, 1.0f, norm_mix);
    convT_job(scr, lru_w_out, WLOUT, DR_, D_, D_, DR_, 0, BIGN, 0, 0, G, bid);
    for (int i = bid * NTHR + otid(); i < 256 * 512; i += G * NTHR) { const int r = i >> 9, k = i & 511; float v = 0.f;
        if (r < 64 && k < 256) v = cmp_w2[(size_t)k * 64 + r]; else if (r >= 64 && r < 128 && k >= 256) v = cmp_w2[(size_t)256 * 64 + (size_t)(k - 256) * 64 + (r - 64)];
        WC2[i] = f2bf(v); }
    rope_table_part(TAB, G, bid);
    pebias_part(scr, cmp_pe, cmp_w1, BIAS1, G, bid);
    cast_rows(x, SB, RS0, G, bid);
    GRID_BAR();
    { pg8::EpiBf16G E; E.O = BIG; E.bias = lru_b_in; E.rsv = RS0; E.ldc = 2 * DR_; E.gelu_cols = DR_; GEMM(pg8::EpiBf16G, SB, WLIN, T_, 2 * DR_, D_, D_, D_, E); }
    if (2 * bid >= G) {
        const int G2 = G - (G + 1) / 2, b2 = bid - (G + 1) / 2;
        convT_job(scr, ffn_wg, WFGU, D_, FF_, FF_, D_, 0, 128, 256, 0, G2, b2, 1.0f, norm_ffn);
        convT_job(scr, ffn_wu, WFGU, D_, FF_, FF_, D_, 0, 128, 256, 128, G2, b2, 1.0f, norm_ffn);
        convT_job(scr, ffn_wd, WFD, FF_, D_, D_, FF_, 0, BIGN, 0, 0, G2, b2);
        convT_job(scr, nsa_w_in, WNIN, D_, NSA_IN_, NSA_PAD_, D_, 0, -1, 0, 0, G2, b2, 1.0f, norm_mix + D_);
        convT_job(scr, nsa_w_out, WNOUT, D_, D_, D_, D_, 0, BIGN, 0, 0, G2, b2);
        convT_job(scr, cmp_w1, WC1K, 2048, 256, 256, 2048, 0, BIGN, 0, 0, G2, b2);
        convT_job(scr, cmp_w1 + (size_t)2048 * 256, WC1V, 2048, 256, 256, 2048, 0, BIGN, 0, 0, G2, b2);
    }
    GRID_BAR();
    for (int u = bid; u < NB_ * NBLK_ * 4; u += G) { lru::lru_unit(lds, u, BIG, conv_w, conv_b, w_a, b_a, w_i, b_i, lam, Y); __syncthreads(); }
    GRID_BAR();
    { pg8::EpiResidB<false> E; E.R = SB; E.X = SB; E.bias = lru_b_out; E.rsq = RSQ1; E.xch = (LAS float*)(lds + 131072); E.ldc = D_; GEMM(pg8::EpiResidB<false>, Y, WLOUT, T_, D_, DR_, DR_, DR_, E); }
    GRID_BAR();
    { pg8::EpiSwiGLU E; E.H = BIG; E.rsq = RSQ1; E.ldc = FF_; E.pad = 0; GEMM(pg8::EpiSwiGLU, SB, WFGU, T_, 2 * FF_, D_, D_, D_, E); }
    GRID_BAR();
    { pg8::EpiResidB<false> E; E.R = SB; E.X = SB; E.bias = nullptr; E.rsq = RSQ2; E.xch = (LAS float*)(lds + 131072); E.ldc = D_; GEMM(pg8::EpiResidB<false>, BIG, WFD, T_, D_, FF_, FF_, FF_, E); }
    GRID_BAR();
    { pg8::EpiNsa E; E.pQ = Q; E.pKC = KC; E.pVC = VC; E.pKS = KS; E.pVS = VS; E.pKW = KW; E.pVW = VW; E.gates = NGT; E.tab = (const float*)TAB; E.rsq = RSQ2; GEMM(pg8::EpiNsa, SB, WNIN, T_, NSA_PAD_, D_, D_, D_, E); }
    if (2 * bid >= G) { const int G2 = G - (G + 1) / 2, b2 = bid - (G + 1) / 2; MOE_FUSED(0, 2, G2, b2); }
    GRID_BAR();
    { pg8::EpiBf16G E; E.O = HC; E.bias = BIAS1; E.rsv = nullptr; E.ldc = 512; E.gelu_cols = 1 << 30; GEMM(pg8::EpiBf16G, KC, WC1K, 16 * NCMP_, 256, 2048, 1024, 2048, E); }
    { pg8::EpiBf16G E; E.O = HC + 256; E.bias = BIAS1 + 256; E.rsv = nullptr; E.ldc = 512; E.gelu_cols = 1 << 30; pg8::Gemm g_; g_.A = VC; g_.Bt = WC1V; g_.M = 16 * NCMP_; g_.N = 256; g_.K = 2048; g_.lda = 1024; g_.ldb = 2048; g_.pad = 0;
      pg8::StaticOrder S_o; S_o.init(16 * NCMP_, 256, G, (bid + G - 32) % G); pg8::gemm_phase<pg8::EpiBf16G, pg8::StaticOrder, true, true>(lds, g_, S_o, E); }
    if (bid < 64 && G > 64) {
        __builtin_amdgcn_fence(__ATOMIC_ACQUIRE, "agent");
        const int hv = bid >= 32 ? 1 : 0;
        pg8::EpiBf16Cols E; E.O = CMP; E.ldc = 256; E.clo = 64 * hv; E.chi = 64 * hv + 64;
        pg8::Gemm g_; g_.A = HC + 256 * hv; g_.Bt = WC2 + 256 * hv; g_.M = 16 * NCMP_; g_.N = 256; g_.K = 256; g_.lda = 512; g_.ldb = 512; g_.pad = 0;
        pg8::StaticOrder S_o; S_o.init(16 * NCMP_, 256, G, hv ? (bid + G - 32) % G : bid); pg8::gemm_phase<pg8::EpiBf16Cols, pg8::StaticOrder, true, true>(lds, g_, S_o, E);
    }
    if (bid >= 64 && G > 64) { MOE_FUSED(2, 7, G - 64, bid - 64); }
    GRID_BAR();
    if (G <= 64) { { pg8::EpiBf16G E; E.O = CMP; E.bias = nullptr; E.rsv = nullptr; E.ldc = 256; E.gelu_cols = 0; GEMM(pg8::EpiBf16G, HC, WC2, 16 * NCMP_, 256, 512, 512, 512, E); } GRID_BAR(); }
    nsa::attn_phase(lds, Q, CMP, KS, VS, KW, VW, NGT, HB, (float*)KC  , G, bid);
    GRID_BAR();
    { pg8::EpiResidB<false> E; E.R = SB; E.X = SB; E.bias = nullptr; E.rsq = nullptr; E.xch = (LAS float*)(lds + 131072); E.ldc = D_; GEMM(pg8::EpiResidB<false>, HB, WNOUT, T_, D_, D_, D_, D_, E); }
    GRID_BAR();
    if (G <= 64) { for (int e = 2; e < 7; ++e) MOE_CONV(e, G, bid); }
    MOE_FUSED(7, 8, G, bid);
    norm_route_rows(lds, SB, norm_ffn + D_, HB, w_router, MCNT, MIDX, MWROW, MCAP, G, bid);
    GRID_BAR();
    {
        LAS unsigned* tt0 = (LAS unsigned*)(lds + MISC_OFF + 64); LAS unsigned* tt1 = tt0 + 256;
        pg8::moe_build_table(tt0, MCNT, 0); pg8::moe_build_table(tt1, MCNT, 1);
        __syncthreads();
        const int NT0 = __builtin_amdgcn_readfirstlane((int)tt0[255]), NT1 = __builtin_amdgcn_readfirstlane((int)tt1[255]);
        const int n0 = NT0 < 64 ? NT0 : 64, n3 = NT1 < 64 ? NT1 : 64;
        for (int ph = 0; ph < 5; ++ph) {
            const int sd = ph - 1, sg = ph;
            const int kd = sd >> 1, kg = sg >> 1;
            const int td0 = (sd == 0) ? 0 : (sd == 1 ? n0 : (sd == 2 ? 0 : NT1 - n3)), tdn = (sd < 0) ? 0 : ((sd == 0) ? n0 : (sd == 1 ? NT0 - n0 : (sd == 2 ? NT1 - n3 : n3)));
            const int tg0 = (sg == 0) ? 0 : (sg == 1 ? n0 : (sg == 2 ? 0 : NT1 - n3)), tgn = (sg > 3) ? 0 : ((sg == 0) ? n0 : (sg == 1 ? NT0 - n0 : (sg == 2 ? NT1 - n3 : n3)));
            const int nd = tdn * (D_ / 256), ng = tgn * (2 * FF_ / 256);
            const int extra = nd > G ? nd - G : 0;
            const int dj0 = bid, dj1 = nd, gj0 = (bid + G - extra) % G, gj1 = ng;
            unsigned char* Hd = (unsigned char*)WSB(O_HID) + (size_t)((sd & 1) ? 1 : 0) * HID_ELEMS; unsigned char* Hg = (unsigned char*)WSB(O_HID) + (size_t)((sg & 1) ? 1 : 0) * HID_ELEMS;
            if (sd >= 0 && dj1 > dj0) { pg8::MoeSched S_m; S_m.init(kd ? tt1 : tt0, MIDX, MCAP, kd, D_ / 256, td0, tdn, dj0, dj1, G); pg8::EpiMoeDown E; E.X = SB; E.idx = MIDX; E.wrow = MWROW; E.ldc = D_; E.cap = MCAP; E.inv = 1.0f / (MOE_SH * MOE_SWD); E.pad = 0;
                pg8::gemm_phase2<pg8::EpiMoeDown, false, true>(lds, (const bf16*)Hd, FF_ / 2, (const bf16*)((unsigned char*)WSB(O_MW) + (size_t)2 * FF_ * D_), (const bf16*)((unsigned char*)WSB(0) + (size_t)2 * FF_ * D_), FF_ / 2, MW_STRIDE, FF_ / 2, S_m, E); }
            if (sg <= 3 && gj1 > gj0) { pg8::MoeSched S_m; S_m.init(kg ? tt1 : tt0, MIDX, MCAP, kg, 2 * FF_ / 256, tg0, tgn, gj0, gj1, G); pg8::EpiSwiGLU2F8 E; E.H = Hg; E.ldc = FF_; E.inv = 1.0f / (MOE_SA * MOE_SW); E.oscale = MOE_SH; E.pad = 0;
                pg8::gemm_phase2<pg8::EpiSwiGLU2F8, true, true>(lds, HB, D_ / 2, WSB(O_MW), WSB(0), D_ / 2, MW_STRIDE, D_ / 2, S_m, E); }
            GRID_BAR();
        }
    }
    final_norm_rows(SB, out, norm_final, G, bid);
}

#undef IN
#undef x
#undef norm_mix
#undef norm_ffn
#undef norm_final
#undef lru_w_in
#undef lru_b_in
#undef conv_w
#undef conv_b
#undef w_a
#undef b_a
#undef w_i
#undef b_i
#undef lam
#undef lru_w_out
#undef lru_b_out
#undef nsa_w_in
#undef cmp_pe
#undef cmp_w1
#undef cmp_w2
#undef nsa_w_out
#undef ffn_wg
#undef ffn_wu
#undef ffn_wd
#undef w_router
#undef moe_wg
#undef moe_wu
#undef moe_wd
#undef WSB
#undef WLIN
#undef WLOUT
#undef WFGU
#undef WFD
#undef WNIN
#undef WNOUT
#undef WC1K
#undef WC1V
#undef WC2
#undef WMGU
#undef WMD
#undef TAB
#undef HB
#undef BIG
#undef Y
#undef Q
#undef KC
#undef VC
#undef KS
#undef VS
#undef KW
#undef VW
#undef HC
#undef CMP
#undef RG
#undef NGT
#undef BIAS1
#undef out
extern "C" void kernel_launch(void* const* d_in, const int* in_sizes, int n_in, void* d_out, int out_size, void* d_ws, size_t ws_size, hipStream_t stream) {
    static int grid = 0;
    if (grid == 0) {
        if (n_in != 27 || out_size != T_ * D_ || ws_size < WS_NEED) { fprintf(stderr, "kernel_launch: unexpected sizes (n_in %d out %d ws %zu)\n", n_in, out_size, ws_size); grid = -1; return; }
        int dev = 0, cus = 0;
        if (hipGetDevice(&dev) != hipSuccess || hipDeviceGetAttribute(&cus, hipDeviceAttributeMultiprocessorCount, dev) != hipSuccess) { grid = -1; return; }
        if (hipFuncSetAttribute((const void*)mega, hipFuncAttributeMaxDynamicSharedMemorySize, LDS_BYTES) != hipSuccess) { fprintf(stderr, "kernel_launch: hipFuncSetAttribute failed\n"); grid = -1; return; }
        int per_cu = 0;
        if (hipOccupancyMaxActiveBlocksPerMultiprocessor(&per_cu, (const void*)mega, NTHR, LDS_BYTES) != hipSuccess || per_cu < 1) { fprintf(stderr, "kernel_launch: occupancy query says %d\n", per_cu); }
        (void)hipGetLastError();
        grid = cus;
    }
    if (grid < 0) return;
    (void)hipMemsetAsync((unsigned char*)d_ws + O_CTL, 0, CTL_BYTES, stream);
    Params p{};
    for (int i = 0; i < 27; ++i) p.in[i] = (const float*)d_in[i];
    p.out = (float*)d_out; p.ws = (unsigned char*)d_ws;
    hipLaunchKernelGGL(mega, dim3(grid), dim3(NTHR), LDS_BYTES, stream, p);
}
```
